# Optimizing an MI355X kernel written in HIP

```python
import jax, jax.numpy as jnp
from jax import lax
import numpy as np

D_MODEL = 1024
BATCH = 16
SEQ = 2048
DEPTH = 1

GLA_HEADS = 4
GLA_KEY = D_MODEL // 2
GLA_VAL = D_MODEL
GLA_DK = GLA_KEY // GLA_HEADS
GLA_DV = GLA_VAL // GLA_HEADS
GLA_GATE_RANK = 16
GLA_GATE_NORM = 16.0
GLA_CHUNK = 64
GLA_NORM_EPS = 1e-5

RWKV_HEAD = 64
RWKV_DIM = D_MODEL
RWKV_HEADS = RWKV_DIM // RWKV_HEAD
DECAY_LORA = 64
AAA_LORA = 64
GATE_LORA = 128
RWKV_GN_EPS = 64e-5

D_FF = 4 * D_MODEL
NORM_EPS = 1e-6

GLA_SIZES = (GLA_KEY, GLA_KEY, GLA_VAL, GLA_VAL, GLA_GATE_RANK)
RWKV_SIZES = (RWKV_DIM, RWKV_DIM, RWKV_DIM, DECAY_LORA, AAA_LORA, GATE_LORA)
GATE_SIZES = (D_MODEL, D_MODEL)
GLA_WIDTH = 2 * GLA_KEY + 2 * GLA_VAL + GLA_GATE_RANK
RWKV_WIDTH = 3 * RWKV_DIM + DECAY_LORA + AAA_LORA + GATE_LORA
IN_WIDTH = GLA_WIDTH + RWKV_WIDTH + 2 * D_MODEL

kernel_name = "gla_rwkv7_gated_hybrid_block"


def _split(t, sizes):
    out, off = [], 0
    for s in sizes:
        out.append(t[..., off:off + s])
        off += s
    return out


def _rmsnorm(x, g):
    xf = x.astype(jnp.float32)
    y = xf * lax.rsqrt(jnp.mean(xf * xf, axis=-1, keepdims=True) + NORM_EPS)
    return (y * g.astype(jnp.float32)).astype(x.dtype)


def _token_shift(z):
    return jnp.pad(z[:, :-1], ((0, 0), (1, 0), (0, 0)))


def _gla_chunked(q, k, v, log_a):
    B, S, H, DK = q.shape
    DV = v.shape[-1]
    C = GLA_CHUNK
    N = S // C
    q = q.reshape(B, N, C, H, DK) * (DK ** -0.5)
    k = k.reshape(B, N, C, H, DK)
    v = v.reshape(B, N, C, H, DV)
    b = jnp.cumsum(log_a.reshape(B, N, C, H, DK), axis=2)
    b_mid = b[:, :, C // 2 - 1:C // 2]
    scores = jnp.einsum('bnthk,bnshk->bnhts', q * jnp.exp(b - b_mid), k * jnp.exp(b_mid - b))
    causal = jnp.tril(jnp.ones((C, C), dtype=bool))
    scores = jnp.where(causal, scores, 0.0)
    o_intra = jnp.einsum('bnhts,bnshv->bnthv', scores, v)
    b_last = b[:, :, -1:]
    q_dec = q * jnp.exp(b)
    k_dec = k * jnp.exp(b_last - b)
    chunk_decay = jnp.exp(b_last[:, :, 0])

    def step(state, inp):
        qd, kd, vc, dec = inp
        o = jnp.einsum('bthk,bhkv->bthv', qd, state)
        state = state * dec[..., None] + jnp.einsum('bthk,bthv->bhkv', kd, vc)
        return state, o

    state0 = jnp.zeros((B, H, DK, DV), jnp.float32)
    xs = (jnp.moveaxis(q_dec, 1, 0), jnp.moveaxis(k_dec, 1, 0), jnp.moveaxis(v, 1, 0), jnp.moveaxis(chunk_decay, 1, 0))
    _, o_inter = lax.scan(step, state0, xs)
    o = o_intra + jnp.moveaxis(o_inter, 0, 1)
    return o.reshape(B, S, H, DV)


def _rwkv7_scan(r, w, k, v, a_, b_):
    B, S, H, N = r.shape

    def step(state, inp):
        rt, wt, kt, vt, at, bt = inp
        sa = jnp.einsum('bhvk,bhk->bhv', state, at)
        state = state * wt[:, :, None, :] + sa[..., None] * bt[:, :, None, :] + vt[..., None] * kt[:, :, None, :]
        y = jnp.einsum('bhvk,bhk->bhv', state, rt)
        return state, y

    state0 = jnp.zeros((B, H, N, N), jnp.float32)
    xs = tuple(jnp.moveaxis(t, 1, 0) for t in (r, w, k, v, a_, b_))
    _, y = lax.scan(step, state0, xs)
    return jnp.moveaxis(y, 0, 1)


def setup_inputs(seed: int = 0) -> dict:
    key = jax.random.key(seed)
    ks = jax.random.split(key, 32)
    f32 = jnp.float32
    L, D = DEPTH, D_MODEL

    def nrm(k, shape, scale):
        return jax.random.normal(k, shape, f32) * scale

    return {
        "x": jax.random.normal(ks[0], (BATCH, SEQ, D), f32),
        "norm_mix": 1.0 + nrm(ks[1], (L, D), 0.05),
        "w_in": nrm(ks[2], (L, D, IN_WIDTH), D ** -0.5),
        "gla_a_w2": nrm(ks[3], (L, GLA_GATE_RANK, GLA_KEY), GLA_GATE_RANK ** -0.5),
        "gla_a_b": 0.5 + nrm(ks[4], (L, GLA_KEY), 0.1),
        "gla_norm": 1.0 + nrm(ks[5], (L, GLA_DV), 0.05),
        "rwkv_mu": jax.random.uniform(ks[6], (L, RWKV_WIDTH), f32, 0.0, 1.0),
        "rwkv_w0": -1.0 + nrm(ks[7], (L, RWKV_DIM), 0.5),
        "rwkv_w_w2": nrm(ks[8], (L, DECAY_LORA, RWKV_DIM), 0.5 * DECAY_LORA ** -0.5),
        "rwkv_a0": nrm(ks[9], (L, RWKV_DIM), 0.3),
        "rwkv_a_w2": nrm(ks[10], (L, AAA_LORA, RWKV_DIM), AAA_LORA ** -0.5),
        "rwkv_g_w2": nrm(ks[11], (L, GATE_LORA, RWKV_DIM), GATE_LORA ** -0.5),
        "rwkv_k_k": 0.85 + nrm(ks[12], (L, RWKV_DIM), 0.05),
        "rwkv_k_a": 1.0 + nrm(ks[13], (L, RWKV_DIM), 0.05),
        "rwkv_r_k": nrm(ks[14], (L, RWKV_HEADS, RWKV_HEAD), 0.1),
        "rwkv_ln_w": 1.0 + nrm(ks[15], (L, RWKV_DIM), 0.05),
        "rwkv_ln_b": nrm(ks[16], (L, RWKV_DIM), 0.02),
        "w_branch_gla": nrm(ks[17], (L, GLA_VAL, D), GLA_VAL ** -0.5),
        "w_branch_rwkv": nrm(ks[18], (L, RWKV_DIM, D), RWKV_DIM ** -0.5),
        "w_out": nrm(ks[19], (L, D, D), D ** -0.5),
        "norm_mlp": 1.0 + nrm(ks[20], (L, D), 0.05),
        "w_up": nrm(ks[21], (L, D, D_FF), D ** -0.5),
        "w_down": nrm(ks[22], (L, D_FF, D), D_FF ** -0.5),
        "norm_final": 1.0 + nrm(ks[23], (D,), 0.05),
    }


def reference(x, norm_mix, w_in, gla_a_w2, gla_a_b, gla_norm, rwkv_mu, rwkv_w0, rwkv_w_w2,
              rwkv_a0, rwkv_a_w2, rwkv_g_w2, rwkv_k_k, rwkv_k_a, rwkv_r_k, rwkv_ln_w, rwkv_ln_b,
              w_branch_gla, w_branch_rwkv, w_out, norm_mlp, w_up, w_down, norm_final):
    f32 = jnp.float32
    B, S, _ = x.shape
    for l in range(DEPTH):
        h = _rmsnorm(x, norm_mix[l])
        proj = h @ w_in[l]
        gla_p, rwkv_p, gate_p = _split(proj, (GLA_WIDTH, RWKV_WIDTH, 2 * D_MODEL))

        g_q, g_k, g_v, g_og, g_al = _split(gla_p.astype(f32), GLA_SIZES)
        log_a = jax.nn.log_sigmoid(g_al @ gla_a_w2[l].astype(f32) + gla_a_b[l].astype(f32)) / GLA_GATE_NORM
        o = _gla_chunked(g_q.reshape(B, S, GLA_HEADS, GLA_DK),
                         g_k.reshape(B, S, GLA_HEADS, GLA_DK),
                         g_v.reshape(B, S, GLA_HEADS, GLA_DV),
                         log_a.reshape(B, S, GLA_HEADS, GLA_DK))
        o = o * lax.rsqrt(jnp.mean(o * o, axis=-1, keepdims=True) + GLA_NORM_EPS) * gla_norm[l].astype(f32)
        y_gla = (o.reshape(B, S, GLA_VAL) * jax.nn.silu(g_og)).astype(x.dtype)

        z = rwkv_p.astype(f32)
        z = z + (_token_shift(z) - z) * rwkv_mu[l].astype(f32)
        r, k, v, wl, al, gl = _split(z, RWKV_SIZES)
        w = -jax.nn.softplus(-(rwkv_w0[l].astype(f32) + jnp.tanh(wl) @ rwkv_w_w2[l].astype(f32))) - 0.5
        decay = jnp.exp(-jnp.exp(w))
        a = jax.nn.sigmoid(rwkv_a0[l].astype(f32) + al @ rwkv_a_w2[l].astype(f32))
        gate = jax.nn.sigmoid(gl) @ rwkv_g_w2[l].astype(f32)
        hs = (B, S, RWKV_HEADS, RWKV_HEAD)
        kk = (k * rwkv_k_k[l].astype(f32)).reshape(hs)
        kk = kk / jnp.maximum(jnp.linalg.norm(kk, axis=-1, keepdims=True), 1e-12)
        k = k * (1.0 + (a - 1.0) * rwkv_k_a[l].astype(f32))
        r4, k4, v4 = r.reshape(hs), k.reshape(hs), v.reshape(hs)
        a4 = a.reshape(hs)
        y = _rwkv7_scan(r4, decay.reshape(hs), k4, v4, -kk, kk * a4)
        mu = jnp.mean(y, axis=-1, keepdims=True)
        var = jnp.mean(jnp.square(y - mu), axis=-1, keepdims=True)
        y = ((y - mu) * lax.rsqrt(var + RWKV_GN_EPS)).reshape(B, S, RWKV_DIM)
        y = y * rwkv_ln_w[l].astype(f32) + rwkv_ln_b[l].astype(f32)
        bonus = jnp.sum(r4 * k4 * rwkv_r_k[l].astype(f32), axis=-1, keepdims=True) * v4
        y_rwkv = ((y + bonus.reshape(B, S, RWKV_DIM)) * gate).astype(x.dtype)

        ga, gb = _split(gate_p, GATE_SIZES)
        mixed = jax.nn.sigmoid(ga) * (y_gla @ w_branch_gla[l]) + jax.nn.sigmoid(gb) * (y_rwkv @ w_branch_rwkv[l])
        x = x + (mixed @ w_out[l]).astype(x.dtype)

        h2 = _rmsnorm(x, norm_mlp[l])
        x = x + (jnp.square(jax.nn.relu(h2 @ w_up[l])) @ w_down[l]).astype(x.dtype)
    return _rmsnorm(x, norm_final)
```

```cpp
#include <hip/hip_runtime.h>
#include <cstdio>
#include <cstdint>
#ifndef MK_SINGLE
#define MK_SINGLE 1
#endif
namespace pg8 {
#define PG8_LAS __attribute__((address_space(3)))
typedef unsigned short bf16_t;
typedef short bf16x8 __attribute__((ext_vector_type(8)));
typedef float f32x4 __attribute__((ext_vector_type(4)));
typedef unsigned u32x4 __attribute__((ext_vector_type(4)));
constexpr int BM = 256, BK = 64, HALF = 128, HTB = HALF * BK * 2  , STAGE_BYTES = 8 * HTB, NXCD = 8, WGM = 8;

__host__ __device__ __forceinline__ int lds_byte(int r, int c) { const int st = (r >> 4) * 2 + (c >> 5), rr = r & 15, cc = c & 31, ob = rr * 64 + cc * 2; return st * 1024 + (ob ^ (((ob >> 9) & 1) << 5)); }
__host__ __device__ __forceinline__ void stage_rc(int b, int& R, int& C) { const int st = b / 1024, sb = b % 1024, swz = sb ^ (((sb >> 9) & 1) << 5); R = (st >> 1) * 16 + swz / 64; C = (st & 1) * 32 + (swz % 64) / 2; }
__host__ __device__ __forceinline__ int perm32(int rho) { const int n = rho >> 4, i = rho & 15; return 8 * (i >> 2) + 4 * n + (i & 3); }

struct Unit { int pm, pn; };
struct Gemm { const bf16_t* A; const bf16_t* Bt; int M, N, K, lda, ldb; };

struct StaticOrder {
    int nM, nN, nwg, G, c;
    __host__ __device__ void init(int M, int N, int G_, int c_) { nM = M / BM; nN = N / BM; nwg = nM * nN; G = G_; c = c_; }
    __host__ __device__ bool next(int i, Unit& u) const {
        const long L = (long)i * G + c; if (L >= nwg) return false;
        int wgid = (int)L; { const int q = nwg / NXCD, r = nwg % NXCD, xcd = wgid % NXCD, off = wgid / NXCD; wgid = (xcd < r ? xcd * (q + 1) : r * (q + 1) + (xcd - r) * q) + off; }
        const int nig = WGM * nN, gid = wgid / nig, fm = gid * WGM, gsz = (nM - fm) < WGM ? (nM - fm) : WGM;
        u.pm = fm + ((wgid % nig) % gsz); u.pn = (wgid % nig) / gsz; return true;
    }
    __device__ __forceinline__ void a_ready(const Unit&) const {}
    __device__ __forceinline__ void done(const Unit&) const {}
};


typedef unsigned u32x2 __attribute__((ext_vector_type(2)));
typedef float f32x2_ __attribute__((ext_vector_type(2))); typedef __bf16 bf16x2_ __attribute__((ext_vector_type(2)));
__device__ __forceinline__ unsigned cvt_pk_bf16(float lo, float hi) { const f32x2_ v = {lo, hi}; return __builtin_bit_cast(unsigned, __builtin_convertvector(v, bf16x2_)); }
__device__ __forceinline__ float bf_lo(unsigned w) { return __uint_as_float(w << 16); }
__device__ __forceinline__ float bf_hi(unsigned w) { return __uint_as_float(w & 0xffff0000u); }
__device__ __forceinline__ float fsigmoid(float x) { return __builtin_amdgcn_rcpf(1.0f + __builtin_amdgcn_exp2f(-1.4426950408889634f * x)); }

template <int ACT> struct EpiStore {
    static constexpr bool PERM = true, AFTER_DRAIN = false; static constexpr int MIDK = 0, MIDSTEP = 0;
    bf16_t* O; int ldc; int ncol;
    __device__ __forceinline__ void operator()(const f32x4 (&acc)[2][2][4][2], const Unit& u, int wr, int wc, int fr, int fq) const {
        const int row0 = u.pm * BM + wr * 64 + fr, col0 = u.pn * BM + wc * 32 + 8 * fq;
#pragma unroll
        for (int ai = 0; ai < 2; ++ai)
#pragma unroll
            for (int m = 0; m < 4; ++m) { bf16_t* rowp = O + (size_t)(row0 + ai * HALF + m * 16) * ldc + col0;
#pragma unroll
                for (int bj = 0; bj < 2; ++bj) { if (col0 + bj * HALF >= ncol) continue;
                    f32x4 v0 = acc[ai][bj][m][0], v1 = acc[ai][bj][m][1];
                    if (ACT == 1) {
#pragma unroll
                        for (int j = 0; j < 4; ++j) { v0[j] = fsigmoid(v0[j]); v1[j] = fsigmoid(v1[j]); } }
                    u32x4 w; w.x = cvt_pk_bf16(v0[0], v0[1]); w.y = cvt_pk_bf16(v0[2], v0[3]); w.z = cvt_pk_bf16(v1[0], v1[1]); w.w = cvt_pk_bf16(v1[2], v1[3]);
                    *(u32x4*)(rowp + bj * HALF) = w; } }
    }
};
template <bool WITH_A2> struct EpiRes {
    static constexpr bool PERM = false, AFTER_DRAIN = false; static constexpr int MIDK = 0, MIDSTEP = 0;
    const float* X; float* X1; bf16_t* A2; int lda2; float* SQ;
    __device__ __forceinline__ void operator()(const f32x4 (&acc)[2][2][4][2], const Unit& u, int wr, int wc, int fr, int fq) const {
        const int row0 = u.pm * BM + wr * 64 + fr, col0 = u.pn * BM + wc * 32 + 4 * fq;
#pragma unroll
        for (int ai = 0; ai < 2; ++ai) {
            f32x4 xv[4][2][2];
#pragma unroll
            for (int m = 0; m < 4; ++m)
#pragma unroll
                for (int bj = 0; bj < 2; ++bj)
#pragma unroll
                    for (int n = 0; n < 2; ++n) xv[m][bj][n] = *(const f32x4*)(X + (size_t)(row0 + ai * HALF + m * 16) * 1024 + col0 + bj * HALF + n * 16);
#pragma unroll
            for (int m = 0; m < 4; ++m) { const int r = row0 + ai * HALF + m * 16; float ss = 0.f;
#pragma unroll
                for (int bj = 0; bj < 2; ++bj)
#pragma unroll
                    for (int n = 0; n < 2; ++n) { const int c = col0 + bj * HALF + n * 16;
                        const f32x4 o = xv[m][bj][n] + acc[ai][bj][m][n];
                        ss += (o[0] * o[0] + o[1] * o[1]) + (o[2] * o[2] + o[3] * o[3]);
                        if (WITH_A2) { u32x2 w; w.x = cvt_pk_bf16(o[0], o[1]); w.y = cvt_pk_bf16(o[2], o[3]); *(u32x2*)(A2 + (size_t)r * lda2 + c) = w; }
                        else *(f32x4*)(X1 + (size_t)r * 1024 + c) = o; }
                ss += __shfl_xor(ss, 16); ss += __shfl_xor(ss, 32);
                if (fq == 0) SQ[(size_t)r * 16 + u.pn * 4 + wc] = ss; } }
    }
};
struct EpiUp {
    static constexpr bool PERM = true, AFTER_DRAIN = false; static constexpr int MIDK = 0, MIDSTEP = 0;
    const float* SQ; bf16_t* H; int ldh; float eps;
    __device__ __forceinline__ void operator()(const f32x4 (&acc)[2][2][4][2], const Unit& u, int wr, int wc, int fr, int fq) const {
        const int row0 = u.pm * BM + wr * 64 + fr, col0 = u.pn * BM + wc * 32 + 8 * fq;
        f32x4 sq[2][4];
#pragma unroll
        for (int ai = 0; ai < 2; ++ai)
#pragma unroll
            for (int m = 0; m < 4; ++m) sq[ai][m] = *(const f32x4*)(SQ + (size_t)(row0 + ai * HALF + m * 16) * 16 + 4 * fq);
#pragma unroll
        for (int ai = 0; ai < 2; ++ai)
#pragma unroll
            for (int m = 0; m < 4; ++m) { const int r = row0 + ai * HALF + m * 16;
                float tot = (sq[ai][m][0] + sq[ai][m][1]) + (sq[ai][m][2] + sq[ai][m][3]); tot += __shfl_xor(tot, 16); tot += __shfl_xor(tot, 32);
                const float rs = __builtin_amdgcn_rsqf(tot * (1.0f / 1024.0f) + eps);
                bf16_t* rowp = H + (size_t)r * ldh + col0;
#pragma unroll
                for (int bj = 0; bj < 2; ++bj) { f32x4 v0 = acc[ai][bj][m][0] * rs, v1 = acc[ai][bj][m][1] * rs;
#pragma unroll
                    for (int j = 0; j < 4; ++j) { v0[j] = fmaxf(v0[j], 0.f); v0[j] *= v0[j]; v1[j] = fmaxf(v1[j], 0.f); v1[j] *= v1[j]; }
                    u32x4 w; w.x = cvt_pk_bf16(v0[0], v0[1]); w.y = cvt_pk_bf16(v0[2], v0[3]); w.z = cvt_pk_bf16(v1[0], v1[1]); w.w = cvt_pk_bf16(v1[2], v1[3]);
                    *(u32x4*)(rowp + bj * HALF) = w; } }
    }
};


struct EpiMerge2 {
    static constexpr bool PERM = true, AFTER_DRAIN = false; static constexpr int MIDK = 16, MIDSTEP = 16;
    const bf16_t* SG; bf16_t* O; int ld;
    __device__ __forceinline__ void mid(f32x4 (&acc)[2][2][4][2], const Unit& u, int t, int wr, int wc, int fr, int fq) const {
        int frv = fr, fqv = fq; asm volatile("" : "+v"(frv), "+v"(fqv));
        const int row0 = u.pm * BM + wr * 64 + frv, col0 = u.pn * BM + wc * 32 + 8 * fqv;
#pragma unroll
        for (int ai = 0; ai < 2; ++ai)
#pragma unroll
            for (int m = 0; m < 4; ++m) { const size_t ro = (size_t)(row0 + ai * HALF + m * 16) * ld + col0;
#pragma unroll
                for (int bj = 0; bj < 2; ++bj) { const u32x4 a = *(const u32x4*)(SG + ro + bj * HALF), b = *(const u32x4*)(SG + ro + bj * HALF + 1024);
                    f32x4& v0 = acc[ai][bj][m][0]; f32x4& v1 = acc[ai][bj][m][1];
                    v0[0] *= bf_lo(a.x) * __builtin_amdgcn_rcpf(bf_lo(b.x)); v0[1] *= bf_hi(a.x) * __builtin_amdgcn_rcpf(bf_hi(b.x));
                    v0[2] *= bf_lo(a.y) * __builtin_amdgcn_rcpf(bf_lo(b.y)); v0[3] *= bf_hi(a.y) * __builtin_amdgcn_rcpf(bf_hi(b.y));
                    v1[0] *= bf_lo(a.z) * __builtin_amdgcn_rcpf(bf_lo(b.z)); v1[1] *= bf_hi(a.z) * __builtin_amdgcn_rcpf(bf_hi(b.z));
                    v1[2] *= bf_lo(a.w) * __builtin_amdgcn_rcpf(bf_lo(b.w)); v1[3] *= bf_hi(a.w) * __builtin_amdgcn_rcpf(bf_hi(b.w)); } }
    }
    __device__ __forceinline__ void operator()(const f32x4 (&acc)[2][2][4][2], const Unit& u, int wr, int wc, int fr, int fq) const {
        const int row0 = u.pm * BM + wr * 64 + fr, col0 = u.pn * BM + wc * 32 + 8 * fq;
        u32x4 sb[2][4][2];
#pragma unroll
        for (int ai = 0; ai < 2; ++ai)
#pragma unroll
            for (int m = 0; m < 4; ++m)
#pragma unroll
                for (int bj = 0; bj < 2; ++bj) sb[ai][m][bj] = *(const u32x4*)(SG + (size_t)(row0 + ai * HALF + m * 16) * ld + col0 + bj * HALF + 1024);
#pragma unroll
        for (int ai = 0; ai < 2; ++ai)
#pragma unroll
            for (int m = 0; m < 4; ++m) { const size_t ro = (size_t)(row0 + ai * HALF + m * 16) * ld + col0;
#pragma unroll
                for (int bj = 0; bj < 2; ++bj) { const size_t off = ro + bj * HALF;
                    const u32x4 s = sb[ai][m][bj];
                    f32x4 v0 = acc[ai][bj][m][0], v1 = acc[ai][bj][m][1];
                    v0[0] *= bf_lo(s.x); v0[1] *= bf_hi(s.x); v0[2] *= bf_lo(s.y); v0[3] *= bf_hi(s.y);
                    v1[0] *= bf_lo(s.z); v1[1] *= bf_hi(s.z); v1[2] *= bf_lo(s.w); v1[3] *= bf_hi(s.w);
                    u32x4 w; w.x = cvt_pk_bf16(v0[0], v0[1]); w.y = cvt_pk_bf16(v0[2], v0[3]); w.z = cvt_pk_bf16(v1[0], v1[1]); w.w = cvt_pk_bf16(v1[2], v1[3]);
                    *(u32x4*)(O + off) = w; } }
    }
};

struct EpiResB {
    static constexpr bool PERM = false, AFTER_DRAIN = false; static constexpr int MIDK = 0, MIDSTEP = 0;
    const bf16_t* X1b; int lda1; float* X2; float* SQ;
    __device__ __forceinline__ void operator()(const f32x4 (&acc)[2][2][4][2], const Unit& u, int wr, int wc, int fr, int fq) const {
        const int row0 = u.pm * BM + wr * 64 + fr, col0 = u.pn * BM + wc * 32 + 4 * fq;
        u32x2 xb[2][4][2][2];
#pragma unroll
        for (int ai = 0; ai < 2; ++ai)
#pragma unroll
            for (int m = 0; m < 4; ++m)
#pragma unroll
                for (int bj = 0; bj < 2; ++bj)
#pragma unroll
                    for (int n = 0; n < 2; ++n) xb[ai][m][bj][n] = *(const u32x2*)(X1b + (size_t)(row0 + ai * HALF + m * 16) * lda1 + col0 + bj * HALF + n * 16);
#pragma unroll
        for (int ai = 0; ai < 2; ++ai)
#pragma unroll
            for (int m = 0; m < 4; ++m) { const int r = row0 + ai * HALF + m * 16; float ss = 0.f;
#pragma unroll
                for (int bj = 0; bj < 2; ++bj)
#pragma unroll
                    for (int n = 0; n < 2; ++n) { const int c = col0 + bj * HALF + n * 16; const u32x2 b2 = xb[ai][m][bj][n];
                        const f32x4 xv = {bf_lo(b2.x), bf_hi(b2.x), bf_lo(b2.y), bf_hi(b2.y)}; const f32x4 o = xv + acc[ai][bj][m][n];
                        *(f32x4*)(X2 + (size_t)r * 1024 + c) = o; ss += (o[0] * o[0] + o[1] * o[1]) + (o[2] * o[2] + o[3] * o[3]); }
                ss += __shfl_xor(ss, 16); ss += __shfl_xor(ss, 32);
                if (fq == 0) SQ[(size_t)r * 16 + u.pn * 4 + wc] = ss; }
    }
};
template <class Epi, class Sched, bool ALIGN_EPI = false, bool SP2 = false>
__device__ __forceinline__ void gemm_phase(PG8_LAS unsigned char* lds, const Gemm g, const Sched& S, const Epi& E) {
    const int tid = threadIdx.x, wid = __builtin_amdgcn_readfirstlane(tid >> 6), lane = tid & 63, wr = wid >> 2, wc = wid & 3, fr = lane & 15, fq = lane >> 4;
    const int K = g.K, nt = K / BK;
    unsigned voffA[2], voffB[2];
#pragma unroll
    for (int i = 0; i < 2; ++i) { int R, C; stage_rc(tid * 16 + i * 8192, R, C); const int Rb = Epi::PERM ? ((R & ~31) + perm32(R & 31)) : R;
        voffA[i] = (unsigned)(R * g.lda + C) * 2u; voffB[i] = (unsigned)(Rb * g.ldb + C) * 2u; }
    const size_t kstep = (size_t)(BK * 2);
    const size_t hstepA = (size_t)HALF * g.lda * 2, hstepB = (size_t)HALF * g.ldb * 2;
    const size_t tstepA = 2 * hstepA, tstepB = 2 * hstepB;
    const unsigned ldsw = (unsigned)wid * 1024u;
    const int aoff = lds_byte(wr * 64 + fr, fq * 8), boff = lds_byte(wc * 32 + fr, fq * 8);
#define PG8_SA(b, h) (((b) * 2 + (h)) * HTB)
#define PG8_SB(b, h) ((4 + (b) * 2 + (h)) * HTB)
#define PG8_STAGE(bufoff, gbase, voff) do { _Pragma("unroll") for (int _i = 0; _i < 2; ++_i) \
        __builtin_amdgcn_global_load_lds((const unsigned*)((const char*)(gbase) + (voff)[_i]), (PG8_LAS unsigned*)(lds + (bufoff) + ldsw + _i * 8192), 16, 0, 0); } while (0)
#define PG8_LDA(dst, b, h) do { _Pragma("unroll") for (int m = 0; m < 4; ++m) _Pragma("unroll") for (int k = 0; k < 2; ++k) dst[m][k] = *(const PG8_LAS bf16x8*)(lds + PG8_SA(b, h) + aoff + m * 2048 + k * 1024); } while (0)
#define PG8_LDB(dst, b, h) do { _Pragma("unroll") for (int n = 0; n < 2; ++n) _Pragma("unroll") for (int k = 0; k < 2; ++k) dst[n][k] = *(const PG8_LAS bf16x8*)(lds + PG8_SB(b, h) + boff + n * 2048 + k * 1024); } while (0)
#define PG8_MMA(ai, bj, At, Bt) do { __builtin_amdgcn_s_setprio(1); _Pragma("unroll") for (int m = 0; m < 4; ++m) _Pragma("unroll") for (int n = 0; n < 2; ++n) _Pragma("unroll") for (int k = 0; k < 2; ++k) \
        acc[ai][bj][m][n] = __builtin_amdgcn_mfma_f32_16x16x32_bf16(Bt[n][k], At[m][k], acc[ai][bj][m][n], 0, 0, 0); __builtin_amdgcn_s_setprio(0); } while (0)
#define PG8_WAIT_V(n) asm volatile("s_waitcnt vmcnt(" #n ")" ::: "memory")
#define PG8_WAIT_L(n) asm volatile("s_waitcnt lgkmcnt(" #n ")" ::: "memory")
#define PG8_BAR __builtin_amdgcn_s_barrier()
#define PG8_SCHED __builtin_amdgcn_sched_barrier(0)
    Unit cur, nxt; int ui = 0;
    if (!S.next(0, cur)) return;
    f32x4 acc[2][2][4][2];
#pragma unroll
    for (int a = 0; a < 2; ++a)
#pragma unroll
        for (int b = 0; b < 2; ++b)
#pragma unroll
            for (int m = 0; m < 4; ++m)
#pragma unroll
                for (int n = 0; n < 2; ++n) acc[a][b][m][n] = (f32x4){0.f, 0.f, 0.f, 0.f};
    bf16x8 At[4][2], B0[2][2], B1[2][2];
    const char* cA = (const char*)g.A + (size_t)cur.pm * tstepA; const char* cB = (const char*)g.Bt + (size_t)cur.pn * tstepB;
    S.a_ready(cur);
    if constexpr (SP2) {
        PG8_STAGE(PG8_SB(0, 0), cB, voffB); PG8_STAGE(PG8_SB(0, 1), cB + hstepB, voffB); PG8_STAGE(PG8_SA(0, 0), cA, voffA); PG8_STAGE(PG8_SA(0, 1), cA + hstepA, voffA);
        if (wr == 1) PG8_BAR;
        PG8_WAIT_V(2); PG8_BAR;
        PG8_STAGE(PG8_SB(1, 0), cB + kstep, voffB); PG8_STAGE(PG8_SA(1, 0), cA + kstep, voffA); PG8_STAGE(PG8_SB(1, 1), cB + hstepB + kstep, voffB);
        PG8_WAIT_V(6); PG8_BAR;
    } else {
        PG8_STAGE(PG8_SB(0, 0), cB, voffB); PG8_STAGE(PG8_SA(0, 0), cA, voffA); PG8_STAGE(PG8_SB(0, 1), cB + hstepB, voffB); PG8_STAGE(PG8_SA(0, 1), cA + hstepA, voffA);
        if (wr == 1) PG8_BAR;
        PG8_WAIT_V(4); PG8_BAR;
        PG8_STAGE(PG8_SB(1, 0), cB + kstep, voffB); PG8_STAGE(PG8_SA(1, 0), cA + kstep, voffA); PG8_STAGE(PG8_SB(1, 1), cB + hstepB + kstep, voffB);
        PG8_WAIT_V(6); PG8_BAR;
    }
    for (;;) {
        const bool has_next = S.next(ui + 1, nxt);
        const char* nA = has_next ? (const char*)g.A + (size_t)nxt.pm * tstepA : cA; const char* nB = has_next ? (const char*)g.Bt + (size_t)nxt.pn * tstepB : cB;
        for (int t = 0; t < nt; t += 2) {
            if constexpr (Epi::MIDK > 0) { if (t > 0 && t <= Epi::MIDK && (t % Epi::MIDSTEP) == 0) E.mid(acc, cur, t, wr, wc, fr, fq); }
            const bool last = (t == nt - 2);
            const char* a1 = cA + (size_t)(t + 1) * kstep;
            const char* a2 = last ? nA : cA + (size_t)(t + 2) * kstep; const char* b2 = last ? nB : cB + (size_t)(t + 2) * kstep;
            const char* a3 = a2 + kstep; const char* b3 = b2 + kstep;
            if (last && has_next) S.a_ready(nxt);
            if constexpr (SP2) {
            PG8_LDB(B0, 0, 0); PG8_LDB(B1, 0, 1); PG8_SCHED; PG8_LDA(At, 0, 0); PG8_STAGE(PG8_SA(1, 1), a1 + hstepA, voffA);
            PG8_WAIT_V(8); PG8_WAIT_L(0); PG8_BAR; PG8_MMA(0, 0, At, B0); PG8_MMA(0, 1, At, B1); PG8_BAR; PG8_SCHED;
            PG8_LDA(At, 0, 1); PG8_STAGE(PG8_SB(0, 0), b2, voffB); PG8_STAGE(PG8_SB(0, 1), b2 + hstepB, voffB); PG8_STAGE(PG8_SA(0, 0), a2, voffA);
            PG8_WAIT_V(8); PG8_WAIT_L(0); PG8_BAR; PG8_MMA(1, 0, At, B0); PG8_MMA(1, 1, At, B1); PG8_BAR; PG8_SCHED;
            PG8_LDB(B0, 1, 0); PG8_LDB(B1, 1, 1); PG8_SCHED; PG8_LDA(At, 1, 0); PG8_STAGE(PG8_SA(0, 1), a2 + hstepA, voffA);
            PG8_WAIT_V(8); PG8_WAIT_L(0); PG8_BAR; PG8_MMA(0, 0, At, B0); PG8_MMA(0, 1, At, B1); PG8_BAR; PG8_SCHED;
            PG8_LDA(At, 1, 1); PG8_STAGE(PG8_SB(1, 0), b3, voffB); PG8_STAGE(PG8_SB(1, 1), b3 + hstepB, voffB); PG8_STAGE(PG8_SA(1, 0), a3, voffA);
            PG8_WAIT_V(8); PG8_WAIT_L(0); PG8_BAR; PG8_MMA(1, 0, At, B0); PG8_MMA(1, 1, At, B1); PG8_BAR; PG8_SCHED;
            } else {
            PG8_LDB(B0, 0, 0); PG8_SCHED; PG8_LDA(At, 0, 0); PG8_STAGE(PG8_SA(1, 1), a1 + hstepA, voffA);
            PG8_WAIT_L(8); PG8_BAR; PG8_WAIT_L(0); PG8_MMA(0, 0, At, B0); PG8_BAR; PG8_SCHED;
            PG8_LDB(B1, 0, 1); PG8_STAGE(PG8_SB(0, 0), b2, voffB);
            PG8_BAR; PG8_WAIT_L(0); PG8_MMA(0, 1, At, B1); PG8_BAR;
            PG8_LDA(At, 0, 1); PG8_STAGE(PG8_SA(0, 0), a2, voffA);
            PG8_BAR; PG8_WAIT_L(0); PG8_MMA(1, 0, At, B0); PG8_BAR; PG8_SCHED;
            PG8_STAGE(PG8_SB(0, 1), b2 + hstepB, voffB);
            PG8_WAIT_V(6); PG8_BAR; PG8_MMA(1, 1, At, B1); PG8_BAR;
            PG8_LDB(B0, 1, 0); PG8_SCHED; PG8_LDA(At, 1, 0); PG8_STAGE(PG8_SA(0, 1), a2 + hstepA, voffA);
            PG8_WAIT_L(8); PG8_BAR; PG8_WAIT_L(0); PG8_MMA(0, 0, At, B0); PG8_BAR; PG8_SCHED;
            PG8_LDB(B1, 1, 1); PG8_STAGE(PG8_SB(1, 0), b3, voffB);
            PG8_BAR; PG8_WAIT_L(0); PG8_MMA(0, 1, At, B1); PG8_BAR;
            PG8_LDA(At, 1, 1); PG8_STAGE(PG8_SA(1, 0), a3, voffA);
            PG8_BAR; PG8_WAIT_L(0); PG8_MMA(1, 0, At, B0); PG8_BAR; PG8_SCHED;
            PG8_STAGE(PG8_SB(1, 1), b3 + hstepB, voffB);
            PG8_WAIT_V(6); PG8_BAR; PG8_MMA(1, 1, At, B1); PG8_BAR;
            }
        }
        if constexpr (ALIGN_EPI) { if (wr == 0) PG8_BAR; }
        if constexpr (!Epi::AFTER_DRAIN) { E(acc, cur, wr, wc, fr, fq); S.done(cur); }
        if (!has_next) break;
#pragma unroll
        for (int a = 0; a < 2; ++a)
#pragma unroll
            for (int b = 0; b < 2; ++b)
#pragma unroll
                for (int m = 0; m < 4; ++m)
#pragma unroll
                    for (int n = 0; n < 2; ++n) acc[a][b][m][n] = (f32x4){0.f, 0.f, 0.f, 0.f};
        cur = nxt; cA = nA; cB = nB; ++ui;
        if constexpr (ALIGN_EPI) { if (wr == 1) PG8_BAR; }
    }
    PG8_WAIT_V(0);
    if constexpr (!ALIGN_EPI) { if (wr == 0) PG8_BAR; }
    PG8_BAR;
    if constexpr (Epi::AFTER_DRAIN) { E.fused(acc, cur, wr, wc, fr, fq, lds, wid, lane); S.done(cur); }
#undef PG8_SA
#undef PG8_SB
#undef PG8_STAGE
#undef PG8_LDA
#undef PG8_LDB
#undef PG8_MMA
#undef PG8_WAIT_V
#undef PG8_WAIT_L
#undef PG8_BAR
#undef PG8_SCHED
}
}

constexpr int NWAVES = 8;
constexpr int BATCH = 16, SEQ = 2048, D = 1024, M = BATCH * SEQ, FF = 4096;
constexpr int LDP = 6656;
constexpr int C_Q = 0, C_K = 512, C_OG = 1024, C_GV = 2048, C_RV = 3072, C_RR = 4096, C_RK = 5120, C_WL = 6144, C_AL = 6208, C_GL = 6272, C_GAL = 6400, NA_VALID = 6416, NA = 6656, NG = 2048;
constexpr int C_MIX = 0, C_A2 = 1024, C_H = 2048, C_SG = 4096;
constexpr float NORM_EPS = 1e-6f, GLA_NORM_EPS = 1e-5f, RWKV_GN_EPS = 64e-5f;

constexpr size_t MiB = 1u << 20;
constexpr size_t WS_CTL = 0, CTL_ZERO_BYTES = 32768;
constexpr size_t WS_WIN = 2 * MiB;
constexpr size_t WS_WBR = 20 * MiB;
constexpr size_t WS_WOUT = 24 * MiB;
constexpr size_t WS_WUP = 26 * MiB;
constexpr size_t WS_WDN = 34 * MiB;
constexpr size_t WS_LW = 42 * MiB;
constexpr size_t WS_LA = WS_LW + 131072;
constexpr size_t WS_LG = WS_LA + 131072;
constexpr size_t WS_GS = 43 * MiB;
constexpr size_t WS_SQ1 = 45 * MiB;
constexpr size_t WS_SQ2 = 47 * MiB;
constexpr size_t WS_P = 64 * MiB;
constexpr size_t WS_LIN = WS_P + (size_t)M * LDP * 2;
constexpr size_t WS_END = WS_LIN + (size_t)M * 256 * 2;
static_assert(WS_END <= 512 * MiB, "d_ws map");
constexpr int CW_BAR = 4096;
constexpr int CW_PAN = 16384;

constexpr int LDS_BYTES = 160 * 1024;
constexpr int MISC_OFF = LDS_BYTES - 256;

#define GAS __attribute__((address_space(1)))
#define LAS __attribute__((address_space(3)))
typedef unsigned short bf16;
typedef unsigned v4u __attribute__((ext_vector_type(4)));
typedef unsigned v2u __attribute__((ext_vector_type(2)));
typedef float f32x4 __attribute__((ext_vector_type(4)));
typedef short bf16x8 __attribute__((ext_vector_type(8)));
typedef GAS unsigned gu32;
#define RLX_AGENT __ATOMIC_RELAXED, __HIP_MEMORY_SCOPE_AGENT
#define LDS_WAIT() asm volatile("s_waitcnt lgkmcnt(0)" ::: "memory")
#define VM_WAIT() asm volatile("s_waitcnt vmcnt(0)" ::: "memory")
__device__ __forceinline__ unsigned f2bf(float f) { unsigned u = __builtin_bit_cast(unsigned, f); return (u + 0x7fffu + ((u >> 16) & 1u)) >> 16; }
typedef float f32x2_t __attribute__((ext_vector_type(2))); typedef __bf16 bf16x2_t __attribute__((ext_vector_type(2)));
__device__ __forceinline__ unsigned pk2(float lo, float hi) { const f32x2_t v = {lo, hi}; return __builtin_bit_cast(unsigned, __builtin_convertvector(v, bf16x2_t)); }
__device__ __forceinline__ float bflo(unsigned w) { return __uint_as_float(w << 16); }
__device__ __forceinline__ float bfhi(unsigned w) { return __uint_as_float(w & 0xffff0000u); }
__device__ __forceinline__ void unpack8(const v4u w, float (&o)[8]) { o[0] = bflo(w.x); o[1] = bfhi(w.x); o[2] = bflo(w.y); o[3] = bfhi(w.y); o[4] = bflo(w.z); o[5] = bfhi(w.z); o[6] = bflo(w.w); o[7] = bfhi(w.w); }
__device__ __forceinline__ v4u pack8(const float (&v)[8]) { v4u w; w.x = pk2(v[0], v[1]); w.y = pk2(v[2], v[3]); w.z = pk2(v[4], v[5]); w.w = pk2(v[6], v[7]); return w; }
__device__ __forceinline__ float fexp(float x) { return __builtin_amdgcn_exp2f(1.4426950408889634f * x); }
__device__ __forceinline__ float fsig(float x) { return __builtin_amdgcn_rcpf(1.0f + fexp(-x)); }
__device__ __forceinline__ float fsoftplus(float x) { return fmaxf(x, 0.f) + __logf(1.0f + fexp(-fabsf(x))); }
__device__ __forceinline__ float add8(float x) {
    x += __int_as_float(__builtin_amdgcn_update_dpp(0, __float_as_int(x), 0xB1, 0xf, 0xf, false));
    x += __int_as_float(__builtin_amdgcn_update_dpp(0, __float_as_int(x), 0x4E, 0xf, 0xf, false));
    x += __int_as_float(__builtin_amdgcn_update_dpp(0, __float_as_int(x), 0x141, 0xf, 0xf, false));
    return x;
}
__device__ __forceinline__ bf16x8 lfrag(const LAS bf16* base, int ld, int r0, int k0, int lane) { return *(const LAS bf16x8*)(base + (r0 + (lane & 15)) * ld + k0 + 8 * (lane >> 4)); }
__device__ __forceinline__ bf16x8 gfrag(const bf16* base, int ld, int r0, int k0, int lane) { return *(const bf16x8*)(base + (size_t)(r0 + (lane & 15)) * ld + k0 + 8 * (lane >> 4)); }
#define MFMA16(a, b, c) __builtin_amdgcn_mfma_f32_16x16x32_bf16((a), (b), (c), 0, 0, 0)

#define XB_TMO      128
#define XB_XCNT(j)  (256  + 64 * (j))
#define XB_XSUB(j)  (1280 + 64 * (j))
#define XB_XGEN(j)  (2304 + 64 * (j))
#define XB_TOP      3328
#define XB_TOPGEN   3392
#define XCD_BAR_WORDS 3456
#define XB_SPIN_CAP (1u << 18)

__device__ __forceinline__ unsigned xb_ld(unsigned* p)              { return __hip_atomic_load(p, __ATOMIC_RELAXED, __HIP_MEMORY_SCOPE_AGENT); }
__device__ __forceinline__ unsigned xb_add(unsigned* p, unsigned v) { return __hip_atomic_fetch_add(p, v, __ATOMIC_RELAXED, __HIP_MEMORY_SCOPE_AGENT); }
__device__ __forceinline__ unsigned xb_xcc_id() { return (unsigned)__builtin_amdgcn_s_getreg((3 << 11) | 20) & 0xFu; }
#define XB_SPIN(cond, bar) do { unsigned _sp = 0; while (cond) { __builtin_amdgcn_s_sleep(1); \
    if ((++_sp & 255u) == 0u) { if (xb_ld(&(bar)[XB_TMO])) break; if (_sp > XB_SPIN_CAP) { atomicAdd(&(bar)[XB_TMO], 1u); break; } } } } while (0)

struct XcdBarrier {
    unsigned* bar; unsigned x;
    volatile LAS unsigned* st;
};

__device__ __forceinline__ XcdBarrier xcd_barrier_post(unsigned* bar, volatile LAS unsigned* st) {
    XcdBarrier b; b.bar = bar; b.x = xb_xcc_id(); b.st = st;
    if (threadIdx.x == 0) (void)xb_add(&bar[XB_XCNT(b.x)], 1u);
    return b;
}
__device__ __forceinline__ void xcd_barrier_complete(unsigned* bar, unsigned x, unsigned& nloc, unsigned& nx) {
    const unsigned G = gridDim.x * gridDim.y * gridDim.z;
    unsigned sum, cnt, mine, sp = 0u;
    for (;;) {
        sum = 0u; cnt = 0u; mine = 0u;
#pragma unroll
        for (unsigned j = 0; j < 16; ++j) { const unsigned c = xb_ld(&bar[XB_XCNT(j)]); sum += c; cnt += (c > 0u) ? 1u : 0u; mine = (j == x) ? c : mine; }
        if (sum == G) break;
        __builtin_amdgcn_s_sleep(1);
        if ((++sp & 255u) == 0u) { if (xb_ld(&bar[XB_TMO])) break; if (sp > XB_SPIN_CAP) { atomicAdd(&bar[XB_TMO], 1u); break; } }
    }
    nloc = mine > 0u ? mine : 1u; nx = cnt > 0u ? cnt : 1u;
}

__device__ __forceinline__ void xcd_barrier(const XcdBarrier& b) {
    asm volatile("s_waitcnt vmcnt(0)" ::: "memory");
    __syncthreads();
    if (threadIdx.x == 0) {
        unsigned* bar = b.bar;
        __builtin_amdgcn_s_waitcnt(0);
        unsigned nloc = b.st[0], nx = b.st[1];
        if (nloc == 0u) { xcd_barrier_complete(bar, b.x, nloc, nx); b.st[0] = nloc; b.st[1] = nx; }
        const unsigned old = xb_add(&bar[XB_XSUB(b.x)], 1u);
        const unsigned gen = old / nloc;
        if (old + 1u == (gen + 1u) * nloc) {
            __builtin_amdgcn_fence(__ATOMIC_RELEASE, "agent");
            asm volatile("s_waitcnt vmcnt(0)" ::: "memory");
            const unsigned og = xb_add(&bar[XB_TOP], 1u);
            const unsigned tg = og / nx;
            if (og + 1u == (tg + 1u) * nx) xb_add(&bar[XB_TOPGEN], 1u);
            else XB_SPIN(xb_ld(&bar[XB_TOPGEN]) == tg, bar);
            __builtin_amdgcn_fence(__ATOMIC_ACQUIRE, "agent");
            xb_add(&bar[XB_XGEN(b.x)], 1u);
            asm volatile("s_waitcnt vmcnt(0)" ::: "memory");
        } else {
            XB_SPIN(xb_ld(&bar[XB_XGEN(b.x)]) == gen, bar);
            __builtin_amdgcn_fence(__ATOMIC_ACQUIRE, "agent");
            asm volatile("s_waitcnt vmcnt(0)" ::: "memory");
        }
    }
    __syncthreads();
}

struct Frame {
    LAS unsigned char* lds;
    volatile LAS unsigned* MISC;
    gu32* ctl;
    int tid, lane, wave;
    int vcu, G;
    const float* in[24]; float* out;
    bf16 *WIN, *WBR, *WOUT, *WUP, *WDN, *LW, *LA, *LG, *P, *XN, *LIN;
    float *GS, *SQ1, *SQ2;
};
enum { I_X = 0, I_NORM_MIX, I_W_IN, I_GLA_A_W2, I_GLA_A_B, I_GLA_NORM, I_MU, I_W0, I_W_W2, I_A0, I_A_W2, I_G_W2, I_K_K, I_K_A, I_R_K, I_LN_W, I_LN_B, I_WB_GLA, I_WB_RWKV, I_W_OUT, I_NORM_MLP, I_W_UP, I_W_DOWN, I_NORM_FINAL };

__device__ __forceinline__ float wave_sum(float v) {
#pragma unroll
    for (int o = 1; o < 64; o <<= 1) v += __shfl_xor(v, o);
    return v;
}
__device__ __forceinline__ int win_src_col(int n) {
    if (n < 1024) return n;
    if (n < 2048) return n + 1024;
    if (n < 3072) return n - 1024;
    if (n < 4096) return n - 3072 + 5136;
    if (n < 6144) return n - 4096 + 3088;
    if (n < 6400) return n - 6144 + 6160;
    if (n < 6416) return n - 6400 + 3072;
    if (n < 6656) return -1;
    return n - 6656 + 6416;
}
__device__ __forceinline__ void tr_item(const float* W, int Nsrc, int sc4, int k0, const float* gk, bf16* WT, int ldk, int drow, int dk0, LAS float* scr, int lane) {
    const int r8 = lane >> 3, c4 = (lane & 7) * 4;
    f32x4 v[8];
#pragma unroll
    for (int i = 0; i < 8; ++i) { const int kk = 8 * i + r8;
        v[i] = (sc4 >= 0) ? *(const f32x4*)(W + (size_t)(k0 + kk) * Nsrc + sc4) : (f32x4){0.f, 0.f, 0.f, 0.f}; }
#pragma unroll
    for (int i = 0; i < 8; ++i) { const int kk = 8 * i + r8; f32x4 x = v[i]; if (gk) x = x * gk[k0 + kk];
        scr[kk * 33 + c4] = x[0]; scr[kk * 33 + c4 + 1] = x[1]; scr[kk * 33 + c4 + 2] = x[2]; scr[kk * 33 + c4 + 3] = x[3]; }
    LDS_WAIT(); asm volatile("" ::: "memory");
    const int c = lane & 7;
#pragma unroll
    for (int j = 0; j < 4; ++j) { const int n = (lane >> 3) + 8 * j; const LAS float* s = scr + (8 * c) * 33 + n;
        v4u o; o.x = pk2(s[0 * 33], s[1 * 33]); o.y = pk2(s[2 * 33], s[3 * 33]); o.z = pk2(s[4 * 33], s[5 * 33]); o.w = pk2(s[6 * 33], s[7 * 33]);
        *(GAS v4u*)(WT + (size_t)(drow + n) * ldk + dk0 + k0 + 8 * c) = o; }
    LDS_WAIT(); asm volatile("" ::: "memory");
}
__device__ __forceinline__ void p0_prologue(Frame& F) {
    LAS float* scr = (LAS float*)(F.lds + F.wave * 16384);
    const int gw = F.vcu * NWAVES + F.wave, NGW = F.G * NWAVES, lane = F.lane;
    constexpr int I_WIN = 16 * 272, I_B = 16 * 32, I_UP = 16 * 128, I_DN = 64 * 32, I_L64 = 32, I_L128 = 64;
    constexpr int NITEMS = I_WIN + 3 * I_B + I_UP + I_DN + 2 * I_L64 + I_L128;
    for (int it = gw; it < NITEMS; it += NGW) {
        int r = it;
        if (r < I_WIN) { const int kb = r / 272, nb = r % 272; tr_item(F.in[I_W_IN], 8464, win_src_col(32 * nb + ((lane & 7) * 4)), 64 * kb, nullptr, F.WIN, 1024, 32 * nb, 0, scr, lane); continue; } r -= I_WIN;
        if (r < I_B) { const int kb = r / 32, nb = r % 32; tr_item(F.in[I_WB_GLA], 1024, 32 * nb + ((lane & 7) * 4), 64 * kb, nullptr, F.WBR, 2048, 32 * nb, 0, scr, lane); continue; } r -= I_B;
        if (r < I_B) { const int kb = r / 32, nb = r % 32; tr_item(F.in[I_WB_RWKV], 1024, 32 * nb + ((lane & 7) * 4), 64 * kb, nullptr, F.WBR, 2048, 32 * nb, 1024, scr, lane); continue; } r -= I_B;
        if (r < I_B) { const int kb = r / 32, nb = r % 32; tr_item(F.in[I_W_OUT], 1024, 32 * nb + ((lane & 7) * 4), 64 * kb, nullptr, F.WOUT, 1024, 32 * nb, 0, scr, lane); continue; } r -= I_B;
        if (r < I_UP) { const int kb = r / 128, nb = r % 128; tr_item(F.in[I_W_UP], 4096, 32 * nb + ((lane & 7) * 4), 64 * kb, F.in[I_NORM_MLP], F.WUP, 1024, 32 * nb, 0, scr, lane); continue; } r -= I_UP;
        if (r < I_DN) { const int kb = r / 32, nb = r % 32; tr_item(F.in[I_W_DOWN], 1024, 32 * nb + ((lane & 7) * 4), 64 * kb, nullptr, F.WDN, 4096, 32 * nb, 0, scr, lane); continue; } r -= I_DN;
        if (r < I_L64) { tr_item(F.in[I_W_W2], 1024, 32 * r + ((lane & 7) * 4), 0, nullptr, F.LW, 64, 32 * r, 0, scr, lane); continue; } r -= I_L64;
        if (r < I_L64) { tr_item(F.in[I_A_W2], 1024, 32 * r + ((lane & 7) * 4), 0, nullptr, F.LA, 64, 32 * r, 0, scr, lane); continue; } r -= I_L64;
        { const int kb = r / 32, nb = r % 32; tr_item(F.in[I_G_W2], 1024, 32 * nb + ((lane & 7) * 4), 64 * kb, nullptr, F.LG, 128, 32 * nb, 0, scr, lane); }
    }
    const float* x = F.in[I_X]; const float* g = F.in[I_NORM_MIX];
    f32x4 gv[4];
#pragma unroll
    for (int j = 0; j < 4; ++j) gv[j] = ((const f32x4*)g)[lane + 64 * j];
    for (int m = gw; m < M; m += 4 * NGW) {
        f32x4 v[4][4]; float ss[4];
#pragma unroll
        for (int u = 0; u < 4; ++u) { const GAS f32x4* xr = (const GAS f32x4*)(x + (size_t)(m + u * NGW) * D) + lane;
#pragma unroll
            for (int j = 0; j < 4; ++j) v[u][j] = xr[64 * j]; }
#pragma unroll
        for (int u = 0; u < 4; ++u) { float s0 = 0.f;
#pragma unroll
            for (int j = 0; j < 4; ++j) s0 += (v[u][j].x * v[u][j].x + v[u][j].y * v[u][j].y) + (v[u][j].z * v[u][j].z + v[u][j].w * v[u][j].w);
            ss[u] = s0; }
#pragma unroll
        for (int o = 1; o < 64; o <<= 1) {
#pragma unroll
            for (int u = 0; u < 4; ++u) ss[u] += __shfl_xor(ss[u], o); }
#pragma unroll
        for (int u = 0; u < 4; ++u) { const float rs = __builtin_amdgcn_rsqf(ss[u] * (1.f / D) + NORM_EPS);
            GAS v2u* o8 = (GAS v2u*)(F.XN + (size_t)(m + u * NGW) * D) + lane;
#pragma unroll
            for (int j = 0; j < 4; ++j) { v2u w; w.x = pk2(v[u][j].x * rs * gv[j].x, v[u][j].y * rs * gv[j].y); w.y = pk2(v[u][j].z * rs * gv[j].z, v[u][j].w * rs * gv[j].w); o8[64 * j] = w; } }
    }
}

__device__ __forceinline__ bf16x8 dfrag(const f32x4 d) {
    const unsigned lo = pk2(d[0], d[1]), hi = pk2(d[2], d[3]); v4u w = {lo, hi, 0u, 0u}; return __builtin_bit_cast(bf16x8, w); }
__device__ __forceinline__ bf16x8 dfrag2(const f32x4 d0, const f32x4 d1) {
    v4u w = {pk2(d0[0], d0[1]), pk2(d0[2], d0[3]), pk2(d1[0], d1[1]), pk2(d1[2], d1[3])}; return __builtin_bit_cast(bf16x8, w); }
__device__ __forceinline__ bf16x8 pfrag(const LAS bf16* base, int ld, int row0, int col0, int col1, int lane) {
    const LAS bf16* p = base + (row0 + (lane & 15)) * ld + 4 * (lane >> 4);
    const v2u a = *(const LAS v2u*)(p + col0), b = *(const LAS v2u*)(p + col1); v4u w = {a.x, a.y, b.x, b.y}; return __builtin_bit_cast(bf16x8, w); }
__device__ __forceinline__ bf16x8 pfrag1(const LAS bf16* base, int ld, int row0, int col0, int lane) {
    const v2u a = *(const LAS v2u*)(base + (row0 + (lane & 15)) * ld + 4 * (lane >> 4) + col0); v4u w = {a.x, a.y, 0u, 0u}; return __builtin_bit_cast(bf16x8, w); }
__device__ __forceinline__ float ldbf(const LAS bf16* p) { return __uint_as_float(((unsigned)*p) << 16); }


typedef short s16x4 __attribute__((ext_vector_type(4)));
__device__ __forceinline__ s16x4 trd4(const LAS bf16* img, int ld, int row, int col0, int lane) {
    const int i = lane & 15; return __builtin_amdgcn_ds_read_tr16_b64_v4i16((LAS s16x4*)(img + (row + (i >> 2)) * ld + col0 + 4 * (i & 3))); }
__device__ __forceinline__ bf16x8 trfrag(const LAS bf16* img, int ld, int rowA, int rowB, int col0, int lane) {
    const s16x4 a = trd4(img, ld, rowA, col0, lane), b = trd4(img, ld, rowB, col0, lane); return (bf16x8){a[0], a[1], a[2], a[3], b[0], b[1], b[2], b[3]}; }
__device__ __forceinline__ bf16x8 trfrag1(const LAS bf16* img, int ld, int rowA, int col0, int lane) {
    const s16x4 a = trd4(img, ld, rowA, col0, lane); return (bf16x8){a[0], a[1], a[2], a[3], 0, 0, 0, 0}; }
__device__ __forceinline__ f32x4 tr2f(const s16x4 a) { return (f32x4){__uint_as_float(((unsigned)(unsigned short)a[0]) << 16), __uint_as_float(((unsigned)(unsigned short)a[1]) << 16), __uint_as_float(((unsigned)(unsigned short)a[2]) << 16), __uint_as_float(((unsigned)(unsigned short)a[3]) << 16)}; }

__device__ __forceinline__ void rwkv_item(Frame& F, int item, bool dry = false) {
    const int b = item >> 4, h = item & 15, tid = F.tid, wave = F.wave;
    LAS unsigned char* L = F.lds;
    LAS bf16* sAt = (LAS bf16*)L; LAS bf16* sRt = sAt + 4608; LAS bf16* sBt = sRt + 4608; LAS bf16* sKt = sBt + 4608;
    LAS bf16* sBh = sKt + 4608; LAS bf16* sKh = sBh + 4608; LAS bf16* sV = sKh + 4608;
    LAS bf16* sAabT = sV + 4608; LAS bf16* sAakT = sAabT + 4608; LAS bf16* sArbT = sAakT + 4608; LAS bf16* sArkT = sArbT + 4608;
    LAS bf16* sWL = sAabT; LAS bf16* sAL = sWL + 4608; LAS bf16* sGL = sAL + 4608;
    LAS bf16* sQhT = sBt; LAS bf16* sMmT = sKt;
    LAS float* sLW = (LAS float*)(sArkT + 4608); LAS float* sY = sLW;
    LAS float* sAa = sLW + 4352; LAS float* sG = sAa + 4352;
    LAS float* sTot = sG + 4352; LAS float* sBonus = sTot + 512; LAS float* sVlast = sBonus + 64; LAS float* sGam = sVlast + 128;
    LAS float* sC = sGam + 64;
    const int t = tid >> 3, kb = tid & 7, hc0 = h * 64 + kb * 8;
    {   const float* mu = F.in[I_MU];
        if (tid < 64) { const int ch = h * 64 + tid;
            sC[tid] = mu[ch]; sC[64 + tid] = mu[1024 + ch]; sC[128 + tid] = mu[2048 + ch]; sC[192 + tid] = F.in[I_K_K][ch]; sC[256 + tid] = F.in[I_K_A][ch];
            sC[320 + tid] = F.in[I_R_K][ch]; sC[384 + tid] = F.in[I_LN_W][ch]; sC[448 + tid] = F.in[I_LN_B][ch]; sC[512 + tid] = mu[3072 + tid]; sC[576 + tid] = mu[3136 + tid]; }
        else if (tid < 192) sC[640 + tid - 64] = mu[3200 + tid - 64];
    }
    const int wci = wave & 3;
    bf16x8 fL[4];
    bf16x8 fA[2];
    if (wave < 4) { fL[0] = gfrag(F.LW, 64, h * 64 + wci * 16, 0, F.lane); fL[1] = gfrag(F.LW, 64, h * 64 + wci * 16, 32, F.lane); fL[2] = fL[0]; fL[3] = fL[0]; fA[0] = fL[0]; fA[1] = fL[0]; }
    else {
#pragma unroll
        for (int ks = 0; ks < 4; ++ks) fL[ks] = gfrag(F.LG, 128, h * 64 + wci * 16, ks * 32, F.lane);
        fA[0] = gfrag(F.LA, 64, h * 64 + wci * 16, 0, F.lane); fA[1] = gfrag(F.LA, 64, h * 64 + wci * 16, 32, F.lane); }
    const float w0c = F.in[I_W0][h * 64 + wci * 16 + (F.lane & 15)], a0c = F.in[I_A0][h * 64 + wci * 16 + (F.lane & 15)];
    f32x4 Hs[4];
#pragma unroll
    for (int i = 0; i < 4; ++i) Hs[i] = (f32x4){0.f, 0.f, 0.f, 0.f};
    LAS bf16* sEx = (LAS bf16*)(sC + 768);
    if (tid < 48) ((LAS v4u*)(sEx + 7 * 192))[tid] = (v4u){0u, 0u, 0u, 0u};
    v4u pr, pk, pv, pwl, pal, pg0, pg1;
    {   const size_t mrow = (size_t)b * SEQ + t; const bf16* row = F.P + mrow * LDP; const bf16* lin = F.LIN + mrow * 256;
        pr = *(const v4u*)(row + C_RR + hc0); pk = *(const v4u*)(row + C_RK + hc0); pv = *(const v4u*)(row + C_RV + hc0);
        pwl = *(const v4u*)(lin + kb * 8); pal = *(const v4u*)(lin + 64 + kb * 8); pg0 = *(const v4u*)(lin + 128 + kb * 8); pg1 = *(const v4u*)(lin + 192 + kb * 8); }
    __syncthreads();
    for (int c = 0; c < 32; ++c) {
        const size_t m0 = (size_t)b * SEQ + c * 64;
        int hc = hc0, lane = F.lane; asm volatile("" : "+v"(hc), "+v"(lane));
        const int c8 = hc & 63, cl = lane & 15, g4 = lane >> 4;
        const v4u cr = pr, ck = pk, cv = pv;
        *(LAS v4u*)(sWL + t * 72 + c8) = pwl; *(LAS v4u*)(sAL + t * 72 + c8) = pal; *(LAS v4u*)(sGL + t * 136 + c8) = pg0; *(LAS v4u*)(sGL + t * 136 + 64 + c8) = pg1;
        {   LAS bf16* ex = sEx + ((wave < 7) ? wave : 7 + (c & 1)) * 192;
            if ((lane >> 3) == 7) { *(LAS v4u*)(ex + c8) = cr; *(LAS v4u*)(ex + 64 + c8) = ck; *(LAS v4u*)(ex + 128 + c8) = cv; } }
        __syncthreads();
        {   const int ch = wci * 16 + cl;
            if (wave < 4) {
                f32x4 lwv[4];
#pragma unroll
                for (int ti = 0; ti < 4; ++ti) { f32x4 accw = {0.f, 0.f, 0.f, 0.f};
#pragma unroll
                    for (int ks = 0; ks < 2; ++ks) accw = MFMA16(lfrag(sWL, 72, ti * 16, ks * 32, lane), fL[ks], accw);
#pragma unroll
                    for (int j = 0; j < 4; ++j) lwv[ti][j] = -0.6065306597126334f * fsig(w0c + accw[j]); }
                float base = 0.f;
#pragma unroll
                for (int ti = 0; ti < 4; ++ti) {
                    lwv[ti][1] += lwv[ti][0]; lwv[ti][2] += lwv[ti][1]; lwv[ti][3] += lwv[ti][2];
                    const float sg = lwv[ti][3];
                    const float s0 = __shfl(sg, cl), s1 = __shfl(sg, cl + 16), s2 = __shfl(sg, cl + 32), s3 = __shfl(sg, cl + 48);
                    const float ex = base + ((g4 > 0) ? s0 : 0.f) + ((g4 > 1) ? s1 : 0.f) + ((g4 > 2) ? s2 : 0.f);
                    base += (s0 + s1) + (s2 + s3);
#pragma unroll
                    for (int j = 0; j < 4; ++j) sLW[(ti * 16 + g4 * 4 + j) * 68 + ch] = lwv[ti][j] + ex; }
            } else {
#pragma unroll
                for (int ti = 0; ti < 4; ++ti) { f32x4 accg = {0.f, 0.f, 0.f, 0.f}, acca = accg;
#pragma unroll
                    for (int ks = 0; ks < 4; ++ks) accg = MFMA16(lfrag(sGL, 136, ti * 16, ks * 32, lane), fL[ks], accg);
#pragma unroll
                    for (int ks = 0; ks < 2; ++ks) acca = MFMA16(lfrag(sAL, 72, ti * 16, ks * 32, lane), fA[ks], acca);
#pragma unroll
                    for (int j = 0; j < 4; ++j) { sG[(ti * 16 + g4 * 4 + j) * 68 + ch] = accg[j]; sAa[(ti * 16 + g4 * 4 + j) * 68 + ch] = fsig(a0c + acca[j]); } } }
        }
            float rr[8], kr[8], vr[8];
            {   const bool first = (lane >> 3) == 0;
                const LAS bf16* ex = sEx + ((wave == 0) ? (7 + ((c + 1) & 1)) : (wave - 1)) * 192;
                v4u qr, qk, qv;
                qr.x = __shfl_up(cr.x, 8); qr.y = __shfl_up(cr.y, 8); qr.z = __shfl_up(cr.z, 8); qr.w = __shfl_up(cr.w, 8);
                qk.x = __shfl_up(ck.x, 8); qk.y = __shfl_up(ck.y, 8); qk.z = __shfl_up(ck.z, 8); qk.w = __shfl_up(ck.w, 8);
                qv.x = __shfl_up(cv.x, 8); qv.y = __shfl_up(cv.y, 8); qv.z = __shfl_up(cv.z, 8); qv.w = __shfl_up(cv.w, 8);
                if (first) { qr = *(const LAS v4u*)(ex + c8); qk = *(const LAS v4u*)(ex + 64 + c8); qv = *(const LAS v4u*)(ex + 128 + c8); }
                float cu[8], pv8[8];
                unpack8(cr, cu); unpack8(qr, pv8);
#pragma unroll
                for (int j = 0; j < 8; ++j) rr[j] = cu[j] + (pv8[j] - cu[j]) * sC[c8 + j];
                unpack8(ck, cu); unpack8(qk, pv8);
#pragma unroll
                for (int j = 0; j < 8; ++j) kr[j] = cu[j] + (pv8[j] - cu[j]) * sC[64 + c8 + j];
                unpack8(cv, cu); unpack8(qv, pv8);
#pragma unroll
                for (int j = 0; j < 8; ++j) vr[j] = cu[j] + (pv8[j] - cu[j]) * sC[128 + c8 + j];
            }
            if (c < 31) { const size_t mrow = m0 + 64 + t; const bf16* row = F.P + mrow * LDP; const bf16* lin = F.LIN + mrow * 256;
                pr = *(const v4u*)(row + C_RR + hc); pk = *(const v4u*)(row + C_RK + hc); pv = *(const v4u*)(row + C_RV + hc);
                pwl = *(const v4u*)(lin + c8); pal = *(const v4u*)(lin + 64 + c8); pg0 = *(const v4u*)(lin + 128 + c8); pg1 = *(const v4u*)(lin + 192 + c8); }
            float kkr[8], ss = 0.f, bon = 0.f;
#pragma unroll
            for (int j = 0; j < 8; ++j) { kkr[j] = kr[j] * sC[192 + c8 + j]; ss += kkr[j] * kkr[j]; }
            ss = add8(ss); const float inv = __builtin_amdgcn_rsqf(fmaxf(ss, 1e-24f));
        __syncthreads();
        {
            float tot[8];
            {   const f32x4 t0 = *(const LAS f32x4*)(sLW + 63 * 68 + c8), t1 = *(const LAS f32x4*)(sLW + 63 * 68 + c8 + 4);
#pragma unroll
                for (int j = 0; j < 4; ++j) { tot[j] = t0[j]; tot[4 + j] = t1[j]; } }
            float inc[8], pl[8], av[8];
            {   const f32x4 i0 = *(const LAS f32x4*)(sLW + t * 68 + c8), i1 = *(const LAS f32x4*)(sLW + t * 68 + c8 + 4);
                const f32x4 a0 = *(const LAS f32x4*)(sAa + t * 68 + c8), a1 = *(const LAS f32x4*)(sAa + t * 68 + c8 + 4);
                f32x4 p0 = {0.f, 0.f, 0.f, 0.f}, p1 = p0;
                if (t > 0) { p0 = *(const LAS f32x4*)(sLW + (t - 1) * 68 + c8); p1 = *(const LAS f32x4*)(sLW + (t - 1) * 68 + c8 + 4); }
#pragma unroll
                for (int j = 0; j < 4; ++j) { inc[j] = i0[j]; inc[4 + j] = i1[j]; pl[j] = p0[j]; pl[4 + j] = p1[j]; av[j] = a0[j]; av[4 + j] = a1[j]; } }
            float at[8], rt[8], bt[8], kt[8], bh[8], kh[8], etot[8];
#pragma unroll
            for (int j = 0; j < 8; ++j) etot[j] = fexp(tot[j]);
#pragma unroll
            for (int j = 0; j < 8; ++j) {
                const float gg = inc[j], gp = pl[j];
                const float a = av[j], kk = kkr[j] * inv, kp = kr[j] * (1.0f + (a - 1.0f) * sC[256 + c8 + j]);
                bon += rr[j] * kp * sC[320 + c8 + j];
                const float eg = fexp(gg), egp = fexp(gp), eng = fexp(-gg), ehl = etot[j] * eng, bv = kk * a;
                at[j] = -kk * egp; rt[j] = rr[j] * eg; bt[j] = bv * eng; kt[j] = kp * eng; bh[j] = bv * ehl; kh[j] = kp * ehl;
                if (t == 0) sGam[c8 + j] = etot[j]; }
            {   LAS bf16* tb = sAt;
                *(LAS v4u*)(tb + t * 72 + c8) = pack8(at); *(LAS v4u*)(tb + 4608 + t * 72 + c8) = pack8(rt);
                *(LAS v4u*)(tb + 2 * 4608 + t * 72 + c8) = pack8(bt); *(LAS v4u*)(tb + 3 * 4608 + t * 72 + c8) = pack8(kt); }
            *(LAS v4u*)(sBh + t * 72 + c8) = pack8(bh); *(LAS v4u*)(sKh + t * 72 + c8) = pack8(kh); *(LAS v4u*)(sV + t * 72 + c8) = pack8(vr);
            bon = add8(bon); if (kb == 0) sBonus[t] = bon;
        }
        __syncthreads();
#pragma unroll
        for (int e = 0; e < 8; ++e) { const int q = wave * 8 + e, o = q >> 4, ti = (q >> 2) & 3, si = q & 3;
            LAS bf16* dst = sAabT + o * 4608; const LAS bf16* as = (o < 2) ? sAt : sRt; const LAS bf16* bs = (o & 1) ? sKt : sBt;
            f32x4 acc = {0.f, 0.f, 0.f, 0.f};
            if (si <= ti) {
#pragma unroll
                for (int ks = 0; ks < 2; ++ks) acc = MFMA16(lfrag(as, 72, ti * 16, ks * 32, lane), lfrag(bs, 72, si * 16, ks * 32, lane), acc); }
            const int sc = si * 16 + cl, tr0 = ti * 16 + g4 * 4, dd = tr0 - sc - ((o < 2) ? 1 : 0);
#pragma unroll
            for (int j = 0; j < 4; ++j) acc[j] = (dd + j >= 0) ? acc[j] : 0.f;
            v2u w; w.x = pk2(acc[0], acc[1]); w.y = pk2(acc[2], acc[3]);
            *(LAS v2u*)(dst + sc * 72 + tr0) = w; }
        {   const int i = wave & 3; f32x4 Pm = {0.f, 0.f, 0.f, 0.f}, Qm = Pm, TT;
#pragma unroll
            for (int ks = 0; ks < 2; ++ks) { const bf16x8 af = lfrag(sAt, 72, i * 16, ks * 32, lane), bf = lfrag(sBt, 72, i * 16, ks * 32, lane);
                Pm = MFMA16(af, bf, Pm); Qm = MFMA16(bf, af, Qm); }
#pragma unroll
            for (int j = 0; j < 4; ++j) { Pm[j] = (cl < 4 * g4 + j) ? Pm[j] : 0.f; Qm[j] = (4 * g4 + j < cl) ? Qm[j] : 0.f;
                TT[j] = Qm[j] + ((4 * g4 + j == cl) ? 1.0f : 0.f); }
            const f32x4 z4 = {0.f, 0.f, 0.f, 0.f};
#pragma unroll
            for (int lvl = 0; lvl < 3; ++lvl) { const bf16x8 pf = dfrag(Pm), qf = dfrag(Qm);
                const f32x4 Pn = MFMA16(qf, pf, z4); if (lvl < 2) Qm = MFMA16(pf, qf, z4);
                Pm = Pn; TT = MFMA16(dfrag(Pm), dfrag(TT), TT); }
            if (wave < 4) { v2u w; w.x = pk2(TT[0], TT[1]); w.y = pk2(TT[2], TT[3]); *(LAS v2u*)((LAS unsigned char*)sTot + (i * 64 + lane) * 8) = w; }
        }
        __syncthreads();
        bf16x8 TTf[4];
#pragma unroll
        for (int i = 0; i < 4; ++i) { const v2u w = *(const LAS v2u*)((LAS unsigned char*)sTot + (i * 64 + lane) * 8); v4u x = {w.x, w.y, 0u, 0u}; TTf[i] = __builtin_bit_cast(bf16x8, x); }
        f32x4 Z[4], QY[4], MN[4];
        const f32x4 zero4 = {0.f, 0.f, 0.f, 0.f};
        if (wave < 4) {
#pragma unroll
            for (int i = 0; i < 4; ++i) Z[i] = tr2f(trd4(sAt, 72, 16 * i + 4 * g4, 16 * wave, lane));
        } else { const int vt = wave - 4;
#pragma unroll
            for (int i = 0; i < 4; ++i) { Z[i] = zero4;
#pragma unroll
                for (int ks = 0; ks < 2; ++ks) Z[i] = MFMA16(trfrag(sAakT, 72, 32 * ks + 8 * g4, 32 * ks + 8 * g4 + 4, 16 * i, lane), trfrag(sV, 72, 32 * ks + 8 * g4, 32 * ks + 8 * g4 + 4, 16 * vt, lane), Z[i]); } }
        Z[0] = MFMA16(TTf[0], dfrag(Z[0]), zero4);
        Z[1] = MFMA16(trfrag1(sAabT, 72, 4 * g4, 16, lane), dfrag(Z[0]), Z[1]);
        Z[1] = MFMA16(TTf[1], dfrag(Z[1]), zero4);
        Z[2] = MFMA16(trfrag(sAabT, 72, 4 * g4, 16 + 4 * g4, 32, lane), dfrag2(Z[0], Z[1]), Z[2]);
        Z[2] = MFMA16(TTf[2], dfrag(Z[2]), zero4);
        Z[3] = MFMA16(trfrag(sAabT, 72, 4 * g4, 16 + 4 * g4, 48, lane), dfrag2(Z[0], Z[1]), Z[3]);
        Z[3] = MFMA16(trfrag1(sAabT, 72, 32 + 4 * g4, 48, lane), dfrag(Z[2]), Z[3]);
        Z[3] = MFMA16(TTf[3], dfrag(Z[3]), zero4);
        {   const bf16x8 z01 = dfrag2(Z[0], Z[1]), z23 = dfrag2(Z[2], Z[3]);
#pragma unroll
            for (int i = 0; i < 4; ++i) {
                QY[i] = MFMA16(trfrag(sArbT, 72, 4 * g4, 16 + 4 * g4, 16 * i, lane), z01, zero4); QY[i] = MFMA16(trfrag(sArbT, 72, 32 + 4 * g4, 48 + 4 * g4, 16 * i, lane), z23, QY[i]);
                MN[i] = MFMA16(trfrag(sBh, 72, 4 * g4, 16 + 4 * g4, 16 * i, lane), z01, zero4); MN[i] = MFMA16(trfrag(sBh, 72, 32 + 4 * g4, 48 + 4 * g4, 16 * i, lane), z23, MN[i]); } }
        if (wave < 4) {
#pragma unroll
            for (int i = 0; i < 4; ++i) {
                const f32x4 radd = tr2f(trd4(sRt, 72, 16 * i + 4 * g4, 16 * wave, lane));
                f32x4 qv = QY[i] + radd, mv = MN[i];
                if (i == wave) { const float gm = sGam[16 * wave + cl];
#pragma unroll
                    for (int j = 0; j < 4; ++j) mv[j] += (4 * g4 + j == cl) ? gm : 0.f; }
                v2u wq; wq.x = pk2(qv[0], qv[1]); wq.y = pk2(qv[2], qv[3]); *(LAS v2u*)(sQhT + (16 * wave + cl) * 72 + 16 * i + 4 * g4) = wq;
                v2u wm; wm.x = pk2(mv[0], mv[1]); wm.y = pk2(mv[2], mv[3]); *(LAS v2u*)(sMmT + (16 * wave + cl) * 72 + 16 * i + 4 * g4) = wm; }
        } else { const int vt = wave - 4;
#pragma unroll
            for (int ks = 0; ks < 2; ++ks) { const bf16x8 vf = trfrag(sV, 72, 32 * ks + 8 * g4, 32 * ks + 8 * g4 + 4, 16 * vt, lane);
#pragma unroll
                for (int i = 0; i < 4; ++i) {
                    QY[i] = MFMA16(trfrag(sArkT, 72, 32 * ks + 8 * g4, 32 * ks + 8 * g4 + 4, 16 * i, lane), vf, QY[i]);
                    MN[i] = MFMA16(trfrag(sKh, 72, 32 * ks + 8 * g4, 32 * ks + 8 * g4 + 4, 16 * i, lane), vf, MN[i]); } } }
        __syncthreads();
        if (wave >= 4) { const int vt = wave - 4;
            const bf16x8 h01 = dfrag2(Hs[0], Hs[1]), h23 = dfrag2(Hs[2], Hs[3]);
#pragma unroll
            for (int i = 0; i < 4; ++i) {
                f32x4 y = MFMA16(trfrag(sQhT, 72, 4 * g4, 16 + 4 * g4, 16 * i, lane), h01, QY[i]); y = MFMA16(trfrag(sQhT, 72, 32 + 4 * g4, 48 + 4 * g4, 16 * i, lane), h23, y);
                f32x4 hn = MFMA16(trfrag(sMmT, 72, 4 * g4, 16 + 4 * g4, 16 * i, lane), h01, MN[i]); hn = MFMA16(trfrag(sMmT, 72, 32 + 4 * g4, 48 + 4 * g4, 16 * i, lane), h23, hn);
                MN[i] = hn;
#pragma unroll
                for (int j = 0; j < 4; ++j) sY[(16 * i + 4 * g4 + j) * 68 + 16 * vt + cl] = y[j]; }
#pragma unroll
            for (int i = 0; i < 4; ++i) Hs[i] = MN[i];
        }
        __syncthreads();
        {   float y[8], s1 = 0.f, s2 = 0.f, o[8];
            const f32x4 y0 = *(const LAS f32x4*)(sY + t * 68 + c8), y1 = *(const LAS f32x4*)(sY + t * 68 + c8 + 4);
            const f32x4 g0 = *(const LAS f32x4*)(sG + t * 68 + c8), g1 = *(const LAS f32x4*)(sG + t * 68 + c8 + 4);
            float vv[8]; unpack8(*(const LAS v4u*)(sV + t * 72 + c8), vv);
#pragma unroll
            for (int j = 0; j < 4; ++j) { y[j] = y0[j]; y[4 + j] = y1[j]; }
#pragma unroll
            for (int j = 0; j < 8; ++j) s1 += y[j];
            const float mean = add8(s1) * (1.0f / 64.0f);
#pragma unroll
            for (int j = 0; j < 8; ++j) { y[j] -= mean; s2 += y[j] * y[j]; }
            const float rstd = __builtin_amdgcn_rsqf(add8(s2) * (1.0f / 64.0f) + RWKV_GN_EPS), bon = sBonus[t];
#pragma unroll
            for (int j = 0; j < 8; ++j) o[j] = (y[j] * rstd * sC[384 + c8 + j] + sC[448 + c8 + j] + bon * vv[j]) * (j < 4 ? g0[j & 3] : g1[j & 3]);
            if (!dry) *(GAS v4u*)(F.P + (m0 + t) * LDP + C_RV + hc) = pack8(o);
        }
    }
    __syncthreads();
}

__device__ __forceinline__ void gla_item(Frame& F, int item, bool dry = false) {
    const int b = item >> 4, h = (item >> 2) & 3, vs = item & 3, tid = F.tid, wave = F.wave;
    LAS bf16* sQE = (LAS bf16*)F.lds; LAS bf16* sKE = sQE + 64 * 136; LAS bf16* sQD = sKE + 64 * 136; LAS bf16* sKD = sQD + 64 * 136; LAS bf16* sST = sKD + 64 * 136;
    LAS bf16* sV = sST + 64 * 136; LAS bf16* sScT = sV + 64 * 72;
    LAS float* sB = (LAS float*)(sScT + 64 * 72); LAS float* sO = (LAS float*)sQE;     LAS bf16* sGalB = (LAS bf16*)(sB + 64 * 132); LAS float* sTot = sB + 64 * 132 + 1024;
    LAS float* sEm = sTot + 512; LAS float* sEp = sEm + 128; LAS float* sEl = sEp + 128; LAS float* sGn = sEl + 128; LAS bf16* sOG = (LAS bf16*)(sGn + 64);
    const int t = tid >> 3, c16 = (tid & 7) * 16, c8 = (tid & 7) * 8;
    for (int i = tid; i < 64 * 136 / 2; i += 512) ((LAS unsigned*)sST)[i] = 0u;
    if (tid < 64) sGn[tid] = F.in[I_GLA_NORM][vs * 64 + tid];
    bf16x8 awf; float ab;
    {   const int lane0 = F.lane, colw = h * 128 + wave * 16 + (lane0 & 15), gq = lane0 >> 4; float a8[8];
#pragma unroll
        for (int j = 0; j < 8; ++j) a8[j] = (gq < 2) ? F.in[I_GLA_A_W2][(8 * gq + j) * 512 + colw] : 0.f;
        awf = __builtin_bit_cast(bf16x8, pack8(a8)); ab = F.in[I_GLA_A_B][colw]; }
    f32x4 accS[4];
#pragma unroll
    for (int i = 0; i < 4; ++i) accS[i] = (f32x4){0.f, 0.f, 0.f, 0.f};
    const float qscale = 0.08838834764831845f;
    v4u pq0, pq1, pk0, pk1, pvv, pga[4];
    const int lane0 = F.lane, cl0 = lane0 & 15, g40 = lane0 >> 4;
    {   const bf16* row = F.P + ((size_t)b * SEQ + t) * LDP;
        pq0 = *(const v4u*)(row + C_Q + h * 128 + c16); pq1 = *(const v4u*)(row + C_Q + h * 128 + c16 + 8); pk0 = *(const v4u*)(row + C_K + h * 128 + c16); pk1 = *(const v4u*)(row + C_K + h * 128 + c16 + 8);
        pvv = *(const v4u*)(row + C_GV + h * 256 + vs * 64 + c8);
#pragma unroll
        for (int ti = 0; ti < 4; ++ti) { pga[ti] = (v4u){0u, 0u, 0u, 0u}; if (g40 < 2) pga[ti] = *(const v4u*)(F.P + ((size_t)b * SEQ + 16 * ti + cl0) * LDP + C_GAL + 8 * g40); } }
    f32x4 bN[4];
#define GLA_G2() do { const f32x4 z4_ = {0.f, 0.f, 0.f, 0.f}; \
        _Pragma("unroll") for (int ti = 0; ti < 4; ++ti) { const f32x4 acc_ = MFMA16(__builtin_bit_cast(bf16x8, pga[ti]), awf, z4_); \
            _Pragma("unroll") for (int j = 0; j < 4; ++j) bN[ti][j] = -fsoftplus(-(ab + acc_[j])) * (1.0f / 16.0f); } \
        float base_ = 0.f; \
        _Pragma("unroll") for (int ti = 0; ti < 4; ++ti) { bN[ti][1] += bN[ti][0]; bN[ti][2] += bN[ti][1]; bN[ti][3] += bN[ti][2]; const float sg_ = bN[ti][3]; \
            const float s0_ = __shfl(sg_, cl0), s1_ = __shfl(sg_, cl0 + 16), s2_ = __shfl(sg_, cl0 + 32), s3_ = __shfl(sg_, cl0 + 48); \
            const float ex_ = base_ + ((g40 > 0) ? s0_ : 0.f) + ((g40 > 1) ? s1_ : 0.f) + ((g40 > 2) ? s2_ : 0.f); base_ += (s0_ + s1_) + (s2_ + s3_); \
            _Pragma("unroll") for (int j = 0; j < 4; ++j) bN[ti][j] += ex_; } } while (0)
    GLA_G2();
    __syncthreads();
    for (int c = 0; c < 32; ++c) {
        const size_t m0 = (size_t)b * SEQ + c * 64;
        int lane = F.lane; asm volatile("" : "+v"(lane));
        const int cl = lane & 15, g4 = lane >> 4;
        const v4u cq0 = pq0, cq1 = pq1, ck0 = pk0, ck1 = pk1;
        *(LAS v4u*)(sV + t * 72 + c8) = pvv;
        {   const int col = wave * 16 + cl;
#pragma unroll
            for (int ti = 0; ti < 4; ++ti)
#pragma unroll
                for (int j = 0; j < 4; ++j) sB[(ti * 16 + g4 * 4 + j) * 132 + col] = bN[ti][j];
            if (g4 == 3) { sEm[col] = fexp(-bN[1][3]); sEp[col] = fexp(bN[1][3]); sEl[col] = fexp(bN[3][3]); } }
        __syncthreads();
        {   float qe[16], ke[16], qd[16], kd[16];
            float q[16], k[16];
            {   float tmp[8];
                unpack8(cq0, tmp);
#pragma unroll
                for (int j = 0; j < 8; ++j) q[j] = tmp[j];
                unpack8(cq1, tmp);
#pragma unroll
                for (int j = 0; j < 8; ++j) q[8 + j] = tmp[j];
                unpack8(ck0, tmp);
#pragma unroll
                for (int j = 0; j < 8; ++j) k[j] = tmp[j];
                unpack8(ck1, tmp);
#pragma unroll
                for (int j = 0; j < 8; ++j) k[8 + j] = tmp[j]; }
            if (c < 31) { const bf16* row = F.P + (m0 + 64 + t) * LDP;
                pq0 = *(const v4u*)(row + C_Q + h * 128 + c16); pq1 = *(const v4u*)(row + C_Q + h * 128 + c16 + 8); pk0 = *(const v4u*)(row + C_K + h * 128 + c16); pk1 = *(const v4u*)(row + C_K + h * 128 + c16 + 8);
                pvv = *(const v4u*)(row + C_GV + h * 256 + vs * 64 + c8);
#pragma unroll
                for (int ti = 0; ti < 4; ++ti) if (g4 < 2) pga[ti] = *(const v4u*)(F.P + (m0 + 64 + 16 * ti + cl) * LDP + C_GAL + 8 * g4); }
#pragma unroll
            for (int j4 = 0; j4 < 4; ++j4) {
                const f32x4 bb = *(const LAS f32x4*)(sB + t * 132 + c16 + 4 * j4), em = *(const LAS f32x4*)(sEm + c16 + 4 * j4), ep = *(const LAS f32x4*)(sEp + c16 + 4 * j4), el = *(const LAS f32x4*)(sEl + c16 + 4 * j4);
#pragma unroll
                for (int jj = 0; jj < 4; ++jj) { const int j = 4 * j4 + jj; const float eb = fexp(bb[jj]), ieb = __builtin_amdgcn_rcpf(eb);
                    qd[j] = q[j] * qscale * eb; qe[j] = qd[j] * em[jj]; const float ki = k[j] * ieb; ke[j] = ki * ep[jj]; kd[j] = ki * el[jj]; } }
            float tmp[8];
#pragma unroll
            for (int hh = 0; hh < 2; ++hh) {
#pragma unroll
                for (int j = 0; j < 8; ++j) tmp[j] = qe[8 * hh + j];
                *(LAS v4u*)(sQE + t * 136 + c16 + 8 * hh) = pack8(tmp);
#pragma unroll
                for (int j = 0; j < 8; ++j) tmp[j] = ke[8 * hh + j];
                *(LAS v4u*)(sKE + t * 136 + c16 + 8 * hh) = pack8(tmp);
#pragma unroll
                for (int j = 0; j < 8; ++j) tmp[j] = qd[8 * hh + j];
                *(LAS v4u*)(sQD + t * 136 + c16 + 8 * hh) = pack8(tmp);
#pragma unroll
                for (int j = 0; j < 8; ++j) tmp[j] = kd[8 * hh + j];
                *(LAS v4u*)(sKD + t * 136 + c16 + 8 * hh) = pack8(tmp); }
        }
        __syncthreads();
#pragma unroll
        for (int e = 0; e < 2; ++e) { const int tile = 2 * wave + e, ti = tile >> 2, si = tile & 3;
            f32x4 acc = {0.f, 0.f, 0.f, 0.f};
            if (si <= ti) {
#pragma unroll
                for (int ks = 0; ks < 4; ++ks) acc = MFMA16(lfrag(sQE, 136, ti * 16, ks * 32, lane), lfrag(sKE, 136, si * 16, ks * 32, lane), acc); }
            const int sc = si * 16 + cl, tr0 = ti * 16 + g4 * 4;
#pragma unroll
            for (int j = 0; j < 4; ++j) acc[j] = (sc <= tr0 + j) ? acc[j] : 0.f;
            v2u w; w.x = pk2(acc[0], acc[1]); w.y = pk2(acc[2], acc[3]);
            *(LAS v2u*)(sScT + sc * 72 + tr0) = w; }
        __syncthreads();
#pragma unroll
        for (int e = 0; e < 2; ++e) { const int tile = 2 * wave + e, ti = tile >> 2, vi = tile & 3;
            f32x4 acc = {0.f, 0.f, 0.f, 0.f};
#pragma unroll
            for (int ks = 0; ks < 2; ++ks) acc = MFMA16(trfrag(sScT, 72, 32 * ks + 8 * g4, 32 * ks + 8 * g4 + 4, 16 * ti, lane), trfrag(sV, 72, 32 * ks + 8 * g4, 32 * ks + 8 * g4 + 4, 16 * vi, lane), acc);
#pragma unroll
            for (int ks = 0; ks < 4; ++ks) acc = MFMA16(lfrag(sQD, 136, ti * 16, ks * 32, lane), lfrag(sST, 136, vi * 16, ks * 32, lane), acc);
#pragma unroll
            for (int j = 0; j < 4; ++j) sO[(ti * 16 + g4 * 4 + j) * 68 + vi * 16 + cl] = acc[j]; }
        {   const f32x4 dec = *(const LAS f32x4*)(sEl + wave * 16 + g4 * 4);
#pragma unroll
            for (int vi = 0; vi < 4; ++vi) accS[vi] = accS[vi] * dec;
#pragma unroll
            for (int ks = 0; ks < 2; ++ks) { const bf16x8 kf = trfrag(sKD, 136, 32 * ks + 8 * g4, 32 * ks + 8 * g4 + 4, 16 * wave, lane);
#pragma unroll
                for (int vi = 0; vi < 4; ++vi) accS[vi] = MFMA16(kf, trfrag(sV, 72, 32 * ks + 8 * g4, 32 * ks + 8 * g4 + 4, 16 * vi, lane), accS[vi]); } }
        if (c < 31) GLA_G2();
        __syncthreads();
#pragma unroll
        for (int vi = 0; vi < 4; ++vi) { v2u w; w.x = pk2(accS[vi][0], accS[vi][1]); w.y = pk2(accS[vi][2], accS[vi][3]);
            *(LAS v2u*)(sST + (vi * 16 + cl) * 136 + wave * 16 + g4 * 4) = w; }
        {   float o[8], ss = 0.f;
            const f32x4 o0 = *(const LAS f32x4*)(sO + t * 68 + c8), o1 = *(const LAS f32x4*)(sO + t * 68 + c8 + 4);
#pragma unroll
            for (int j = 0; j < 4; ++j) { o[j] = o0[j]; o[4 + j] = o1[j]; }
#pragma unroll
            for (int j = 0; j < 8; ++j) ss += o[j] * o[j];
            ss = add8(ss);
            if (!dry) { if ((tid & 7) == 0) F.GS[(m0 + t) * 16 + h * 4 + vs] = ss;
                *(GAS v4u*)(F.P + (m0 + t) * LDP + C_GV + h * 256 + vs * 64 + c8) = pack8(o); }
        }
    }
}
#undef GLA_G2

__device__ __forceinline__ void gla_fixup(Frame& F) {
    const int gw = F.vcu * NWAVES + F.wave, NGW = F.G * NWAVES, lane = F.lane;
    const int hd = lane >> 4, v0 = (lane & 15) * 16;
    float gn[16];
#pragma unroll
    for (int j = 0; j < 16; ++j) gn[j] = F.in[I_GLA_NORM][v0 + j];
    for (int m = gw; m < M; m += 2 * NGW) {
        v4u ov[2][2], gvv[2][2]; float rs[2];
#pragma unroll
        for (int u = 0; u < 2; ++u) { const int mm = m + u * NGW; const bf16* prow = F.P + (size_t)mm * LDP;
            const f32x4 g4 = *(const f32x4*)(F.GS + (size_t)mm * 16 + hd * 4);
#pragma unroll
            for (int hh = 0; hh < 2; ++hh) { ov[u][hh] = *(const v4u*)(prow + C_GV + lane * 16 + 8 * hh); gvv[u][hh] = *(const v4u*)(prow + C_OG + lane * 16 + 8 * hh); }
            rs[u] = 1.0f / sqrtf(((g4[0] + g4[1]) + (g4[2] + g4[3])) * (1.0f / 256.0f) + GLA_NORM_EPS);
        }
#pragma unroll
        for (int u = 0; u < 2; ++u) { bf16* prow = F.P + (size_t)(m + u * NGW) * LDP;
#pragma unroll
            for (int hh = 0; hh < 2; ++hh) { float o[8], g[8]; unpack8(ov[u][hh], o); unpack8(gvv[u][hh], g);
#pragma unroll
                for (int j = 0; j < 8; ++j) o[j] = o[j] * rs[u] * gn[8 * hh + j] * (g[j] * fsig(g[j]));
                *(GAS v4u*)(prow + C_GV + lane * 16 + 8 * hh) = pack8(o); } }
    }
}
__device__ __forceinline__ void final_norm(Frame& F) {
    const int gw = F.vcu * NWAVES + F.wave, NGW = F.G * NWAVES, lane = F.lane;
    f32x4 gv[4];
#pragma unroll
    for (int j = 0; j < 4; ++j) gv[j] = ((const f32x4*)F.in[I_NORM_FINAL])[lane + 64 * j];
    for (int m = gw; m < M; m += 2 * NGW) {
        float rs[2]; f32x4 v[2][4];
#pragma unroll
        for (int u = 0; u < 2; ++u) { const int mm = m + u * NGW;
            const f32x4* sq = (const f32x4*)(F.SQ2 + (size_t)mm * 16); const f32x4 s0 = sq[0], s1 = sq[1], s2 = sq[2], s3 = sq[3];
            const GAS f32x4* xr = (const GAS f32x4*)(F.out + (size_t)mm * D) + lane;
#pragma unroll
            for (int j = 0; j < 4; ++j) v[u][j] = xr[64 * j];
            const float tot = ((s0[0] + s0[1]) + (s0[2] + s0[3])) + ((s1[0] + s1[1]) + (s1[2] + s1[3])) + ((s2[0] + s2[1]) + (s2[2] + s2[3])) + ((s3[0] + s3[1]) + (s3[2] + s3[3]));
            rs[u] = 1.0f / sqrtf(tot * (1.0f / 1024.0f) + NORM_EPS); }
#pragma unroll
        for (int u = 0; u < 2; ++u) { GAS f32x4* xr = (GAS f32x4*)(F.out + (size_t)(m + u * NGW) * D) + lane;
#pragma unroll
            for (int j = 0; j < 4; ++j) xr[64 * j] = v[u][j] * rs[u] * gv[j]; }
    }
}
__device__ __forceinline__ void lin_pass(Frame& F, int blk) {
    const int tid = F.tid, r = tid >> 2, q = tid & 3; const size_t m = (size_t)blk * 128 + r;
    const bf16* row = F.P + m * LDP + C_WL + q * 64; const bool hasprev = (m % SEQ) != 0; const float* mu = F.in[I_MU] + 3072 + q * 64;
#pragma unroll
    for (int p = 0; p < 8; ++p) { float cur[8], prv[8], z[8];
        unpack8(*(const v4u*)(row + 8 * p), cur);
        if (hasprev) unpack8(*(const v4u*)(row - LDP + 8 * p), prv); else {
#pragma unroll
            for (int j = 0; j < 8; ++j) prv[j] = 0.f; }
#pragma unroll
        for (int j = 0; j < 8; ++j) { const float zz = cur[j] + (prv[j] - cur[j]) * mu[8 * p + j];
            z[j] = (q == 0) ? (1.0f - 2.0f * __builtin_amdgcn_rcpf(1.0f + fexp(2.0f * zz))) : ((q == 1) ? zz : fsig(zz)); }
        *(GAS v4u*)(F.LIN + m * 256 + q * 64 + 8 * p) = pack8(z); }
}
constexpr int N_PHASES = 10;
struct Args { const float* in[24]; float* out; unsigned char* ws; int ph_lo, ph_hi; };
__global__ void __launch_bounds__(NWAVES * 64, 2) mk_fwd(Args args) {
    extern __shared__ __attribute__((aligned(16))) unsigned char lds[];
    Frame F;
    F.lds = (LAS unsigned char*)lds;
    F.MISC = (volatile LAS unsigned*)(F.lds + MISC_OFF);
    F.tid = threadIdx.x; F.lane = F.tid & 63; F.wave = __builtin_amdgcn_readfirstlane(F.tid >> 6);
    F.G = gridDim.x; { const int bx = blockIdx.x; F.vcu = (F.G % 8 == 0) ? (bx % 8) * (F.G / 8) + bx / 8 : bx; }
    unsigned char* ws = args.ws;
    F.ctl = (gu32*)(ws + WS_CTL);
#pragma unroll
    for (int i = 0; i < 24; ++i) F.in[i] = args.in[i];
    F.out = args.out;
    F.WIN = (bf16*)(ws + WS_WIN); F.WBR = (bf16*)(ws + WS_WBR); F.WOUT = (bf16*)(ws + WS_WOUT); F.WUP = (bf16*)(ws + WS_WUP); F.WDN = (bf16*)(ws + WS_WDN);
    F.LW = (bf16*)(ws + WS_LW); F.LA = (bf16*)(ws + WS_LA); F.LG = (bf16*)(ws + WS_LG); F.P = (bf16*)(ws + WS_P); F.XN = (bf16*)args.out;
    F.LIN = (bf16*)(ws + WS_LIN);
    F.GS = (float*)(ws + WS_GS); F.SQ1 = (float*)(ws + WS_SQ1); F.SQ2 = (float*)(ws + WS_SQ2);
    if (F.tid < 64) ((LAS unsigned*)(F.lds + MISC_OFF))[F.tid] = 0u;
    __syncthreads();
    const int lo = args.ph_lo, hi = args.ph_hi;
    XcdBarrier bar; bar.bar = (unsigned*)(F.ctl + CW_BAR); bar.x = 0; bar.st = nullptr;
    if (hi - lo > 1) bar = xcd_barrier_post((unsigned*)(F.ctl + CW_BAR), F.MISC + 8);
#define IN(k) (lo <= (k) && (k) < hi)
#define SEAM(k) do { if (IN(k) && IN((k) + 1)) xcd_barrier(bar); } while (0)
    LAS unsigned char* ring = F.lds;

    if (IN(0)) { p0_prologue(F); } SEAM(0);
    if (IN(1)) {
        pg8::Gemm g{F.XN, F.WIN, M, NA, D, D, D}; pg8::StaticOrder S; S.init(M, NA, F.G, (int)blockIdx.x);
        pg8::EpiStore<0> E{F.P, LDP, NA_VALID};
        pg8::gemm_phase<pg8::EpiStore<0>, pg8::StaticOrder, true, true>(ring, g, S, E);
    } SEAM(1);
#ifndef RWKV_IMPL
#define RWKV_IMPL rwkv_item
#endif
#ifndef GLA_IMPL
#define GLA_IMPL gla_item
#endif
    if (IN(2)) { if (F.vcu < BATCH * 16) { lin_pass(F, F.vcu); GLA_IMPL(F, F.vcu); } } SEAM(2);
    if (IN(3)) { __syncthreads(); if (F.vcu < BATCH * 16) RWKV_IMPL(F, F.vcu); gla_fixup(F); }
    SEAM(3);
    if (IN(4)) {
        pg8::Gemm g{F.XN, F.WIN + (size_t)NA * D, M, NG, D, D, D}; pg8::StaticOrder S; S.init(M, NG, F.G, (int)blockIdx.x);
        pg8::EpiStore<1> E{F.P + C_SG, LDP, NG};
        pg8::gemm_phase<pg8::EpiStore<1>, pg8::StaticOrder, true, true>(ring, g, S, E);
    } SEAM(4);
    if (IN(5)) {
        pg8::Gemm g{F.P + C_GV, F.WBR, M, D, 2 * D, LDP, 2 * D}; pg8::StaticOrder S; S.init(M, D, F.G, (int)blockIdx.x);
        pg8::EpiMerge2 E{F.P + C_SG, F.P + C_MIX, LDP};
        pg8::gemm_phase<pg8::EpiMerge2, pg8::StaticOrder, true, true>(ring, g, S, E);
    } SEAM(5);
    if (IN(6)) {
        pg8::Gemm g{F.P + C_MIX, F.WOUT, M, D, D, LDP, D}; pg8::StaticOrder S; S.init(M, D, F.G, (int)blockIdx.x);
        pg8::EpiRes<true> E{F.in[I_X], F.out, F.P + C_A2, LDP, F.SQ1};
        pg8::gemm_phase<pg8::EpiRes<true>, pg8::StaticOrder, true, true>(ring, g, S, E);
    } SEAM(6);
    if (IN(7)) {
        pg8::Gemm g{F.P + C_A2, F.WUP, M, FF, D, LDP, D}; pg8::StaticOrder S; S.init(M, FF, F.G, (int)blockIdx.x);
        pg8::EpiUp E{F.SQ1, F.P + C_H, LDP, NORM_EPS};
        pg8::gemm_phase<pg8::EpiUp, pg8::StaticOrder, true, true>(ring, g, S, E);
    } SEAM(7);
    if (IN(8)) {
        pg8::Gemm g{F.P + C_H, F.WDN, M, D, FF, LDP, FF}; pg8::StaticOrder S; S.init(M, D, F.G, (int)blockIdx.x);
        pg8::EpiResB E{F.P + C_A2, LDP, F.out, F.SQ2};
        pg8::gemm_phase<pg8::EpiResB, pg8::StaticOrder, true, true>(ring, g, S, E);
    } SEAM(8);
    if (IN(9)) { final_norm(F); }
#undef IN
#undef SEAM
}

extern "C" void kernel_launch(void* const* d_in, const int* in_sizes, int n_in, void* d_out, int out_size, void* d_ws, size_t ws_size, hipStream_t stream) {
    static int grid = 0;
    if (grid == 0) {
        if (n_in != 24 || in_sizes[0] != M * D || out_size != M * D || ws_size < WS_END) { fprintf(stderr, "kernel_launch: unexpected shapes (n_in %d, in0 %d, out %d, ws %zu, need %zu)\n", n_in, n_in > 0 ? in_sizes[0] : -1, out_size, ws_size, (size_t)WS_END); grid = -1; return; }
        int dev = 0, cus = 0, per_cu = 0;
        if (hipGetDevice(&dev) != hipSuccess || hipDeviceGetAttribute(&cus, hipDeviceAttributeMultiprocessorCount, dev) != hipSuccess) { grid = -1; return; }
        if (hipFuncSetAttribute((const void*)mk_fwd, hipFuncAttributeMaxDynamicSharedMemorySize, LDS_BYTES) != hipSuccess) { fprintf(stderr, "kernel_launch: hipFuncSetAttribute failed\n"); grid = -1; return; }
        if (hipOccupancyMaxActiveBlocksPerMultiprocessor(&per_cu, (const void*)mk_fwd, NWAVES * 64, LDS_BYTES) != hipSuccess || per_cu < 1) { fprintf(stderr, "kernel_launch: occupancy query says %d blocks per CU\n", per_cu); }
        (void)hipGetLastError();
        grid = cus;
        if (grid != 256) { fprintf(stderr, "kernel_launch: built for a 256-CU device (one mixer item per workgroup); found %d CUs; nothing launched\n", cus); grid = -1; return; }
    }
    if (grid < 0) return;
    (void)hipMemsetAsync((char*)d_ws + WS_CTL, 0, CTL_ZERO_BYTES, stream);
    Args a{};
    for (int i = 0; i < 24; ++i) a.in[i] = (const float*)d_in[i];
    a.out = (float*)d_out; a.ws = (unsigned char*)d_ws;
#if MK_SINGLE
    a.ph_lo = 0; a.ph_hi = N_PHASES;
    hipLaunchKernelGGL(mk_fwd, dim3(grid), dim3(NWAVES * 64), LDS_BYTES, stream, a);
#else
    for (int p = 0; p < N_PHASES; ++p) { a.ph_lo = p; a.ph_hi = p + 1; hipLaunchKernelGGL(mk_fwd, dim3(grid), dim3(NWAVES * 64), LDS_BYTES, stream, a); }
#endif
}
```

```cpp
#include <hip/hip_runtime.h>
#include <cstdio>
#include <cstdint>
#ifndef MK_SINGLE
#define MK_SINGLE 1
#endif
namespace pg8 {
#define PG8_LAS __attribute__((address_space(3)))
typedef unsigned short bf16_t;
typedef short bf16x8 __attribute__((ext_vector_type(8)));
typedef float f32x4 __attribute__((ext_vector_type(4)));
typedef unsigned u32x4 __attribute__((ext_vector_type(4)));
constexpr int BM = 256, BK = 64, HALF = 128, HTB = HALF * BK * 2  , STAGE_BYTES = 8 * HTB, NXCD = 8, WGM = 8;

__host__ __device__ __forceinline__ int lds_byte(int r, int c) { const int st = (r >> 4) * 2 + (c >> 5), rr = r & 15, cc = c & 31, ob = rr * 64 + cc * 2; return st * 1024 + (ob ^ (((ob >> 9) & 1) << 5)); }
__host__ __device__ __forceinline__ void stage_rc(int b, int& R, int& C) { const int st = b / 1024, sb = b % 1024, swz = sb ^ (((sb >> 9) & 1) << 5); R = (st >> 1) * 16 + swz / 64; C = (st & 1) * 32 + (swz % 64) / 2; }
__host__ __device__ __forceinline__ int perm32(int rho) { const int n = rho >> 4, i = rho & 15; return 8 * (i >> 2) + 4 * n + (i & 3); }

struct Unit { int pm, pn; };
struct Gemm { const bf16_t* A; const bf16_t* Bt; int M, N, K, lda, ldb; };

struct StaticOrder {
    int nM, nN, nwg, G, c;
    __host__ __device__ void init(int M, int N, int G_, int c_) { nM = M / BM; nN = N / BM; nwg = nM * nN; G = G_; c = c_; }
    __host__ __device__ bool next(int i, Unit& u) const {
        const long L = (long)i * G + c; if (L >= nwg) return false;
        int wgid = (int)L; { const int q = nwg / NXCD, r = nwg % NXCD, xcd = wgid % NXCD, off = wgid / NXCD; wgid = (xcd < r ? xcd * (q + 1) : r * (q + 1) + (xcd - r) * q) + off; }
        const int nig = WGM * nN, gid = wgid / nig, fm = gid * WGM, gsz = (nM - fm) < WGM ? (nM - fm) : WGM;
        u.pm = fm + ((wgid % nig) % gsz); u.pn = (wgid % nig) / gsz; return true;
    }
    __device__ __forceinline__ void a_ready(const Unit&) const {}
    __device__ __forceinline__ void done(const Unit&) const {}
};


typedef unsigned u32x2 __attribute__((ext_vector_type(2)));
typedef float f32x2_ __attribute__((ext_vector_type(2))); typedef __bf16 bf16x2_ __attribute__((ext_vector_type(2)));
__device__ __forceinline__ unsigned cvt_pk_bf16(float lo, float hi) { const f32x2_ v = {lo, hi}; return __builtin_bit_cast(unsigned, __builtin_convertvector(v, bf16x2_)); }
__device__ __forceinline__ float bf_lo(unsigned w) { return __uint_as_float(w << 16); }
__device__ __forceinline__ float bf_hi(unsigned w) { return __uint_as_float(w & 0xffff0000u); }
__device__ __forceinline__ float fsigmoid(float x) { return __builtin_amdgcn_rcpf(1.0f + __builtin_amdgcn_exp2f(-1.4426950408889634f * x)); }

template <int ACT> struct EpiStore {
    static constexpr bool PERM = true, AFTER_DRAIN = false; static constexpr int MIDK = 0, MIDSTEP = 0;
    bf16_t* O; int ldc; int ncol;
    __device__ __forceinline__ void operator()(const f32x4 (&acc)[2][2][4][2], const Unit& u, int wr, int wc, int fr, int fq) const {
        const int row0 = u.pm * BM + wr * 64 + fr, col0 = u.pn * BM + wc * 32 + 8 * fq;
#pragma unroll
        for (int ai = 0; ai < 2; ++ai)
#pragma unroll
            for (int m = 0; m < 4; ++m) { bf16_t* rowp = O + (size_t)(row0 + ai * HALF + m * 16) * ldc + col0;
#pragma unroll
                for (int bj = 0; bj < 2; ++bj) { if (col0 + bj * HALF >= ncol) continue;
                    f32x4 v0 = acc[ai][bj][m][0], v1 = acc[ai][bj][m][1];
                    if (ACT == 1) {
#pragma unroll
                        for (int j = 0; j < 4; ++j) { v0[j] = fsigmoid(v0[j]); v1[j] = fsigmoid(v1[j]); } }
                    u32x4 w; w.x = cvt_pk_bf16(v0[0], v0[1]); w.y = cvt_pk_bf16(v0[2], v0[3]); w.z = cvt_pk_bf16(v1[0], v1[1]); w.w = cvt_pk_bf16(v1[2], v1[3]);
                    *(u32x4*)(rowp + bj * HALF) = w; } }
    }
};
template <bool WITH_A2> struct EpiRes {
    static constexpr bool PERM = false, AFTER_DRAIN = false; static constexpr int MIDK = 0, MIDSTEP = 0;
    const float* X; float* X1; bf16_t* A2; int lda2; float* SQ;
    __device__ __forceinline__ void operator()(const f32x4 (&acc)[2][2][4][2], const Unit& u, int wr, int wc, int fr, int fq) const {
        const int row0 = u.pm * BM + wr * 64 + fr, col0 = u.pn * BM + wc * 32 + 4 * fq;
#pragma unroll
        for (int ai = 0; ai < 2; ++ai) {
            f32x4 xv[4][2][2];
#pragma unroll
            for (int m = 0; m < 4; ++m)
#pragma unroll
                for (int bj = 0; bj < 2; ++bj)
#pragma unroll
                    for (int n = 0; n < 2; ++n) xv[m][bj][n] = *(const f32x4*)(X + (size_t)(row0 + ai * HALF + m * 16) * 1024 + col0 + bj * HALF + n * 16);
#pragma unroll
            for (int m = 0; m < 4; ++m) { const int r = row0 + ai * HALF + m * 16; float ss = 0.f;
#pragma unroll
                for (int bj = 0; bj < 2; ++bj)
#pragma unroll
                    for (int n = 0; n < 2; ++n) { const int c = col0 + bj * HALF + n * 16;
                        const f32x4 o = xv[m][bj][n] + acc[ai][bj][m][n];
                        ss += (o[0] * o[0] + o[1] * o[1]) + (o[2] * o[2] + o[3] * o[3]);
                        if (WITH_A2) { u32x2 w; w.x = cvt_pk_bf16(o[0], o[1]); w.y = cvt_pk_bf16(o[2], o[3]); *(u32x2*)(A2 + (size_t)r * lda2 + c) = w; }
                        else *(f32x4*)(X1 + (size_t)r * 1024 + c) = o; }
                ss += __shfl_xor(ss, 16); ss += __shfl_xor(ss, 32);
                if (fq == 0) SQ[(size_t)r * 16 + u.pn * 4 + wc] = ss; } }
    }
};
struct EpiUp {
    static constexpr bool PERM = true, AFTER_DRAIN = false; static constexpr int MIDK = 0, MIDSTEP = 0;
    const float* SQ; bf16_t* H; int ldh; float eps;
    __device__ __forceinline__ void operator()(const f32x4 (&acc)[2][2][4][2], const Unit& u, int wr, int wc, int fr, int fq) const {
        const int row0 = u.pm * BM + wr * 64 + fr, col0 = u.pn * BM + wc * 32 + 8 * fq;
        f32x4 sq[2][4];
#pragma unroll
        for (int ai = 0; ai < 2; ++ai)
#pragma unroll
            for (int m = 0; m < 4; ++m) sq[ai][m] = *(const f32x4*)(SQ + (size_t)(row0 + ai * HALF + m * 16) * 16 + 4 * fq);
#pragma unroll
        for (int ai = 0; ai < 2; ++ai)
#pragma unroll
            for (int m = 0; m < 4; ++m) { const int r = row0 + ai * HALF + m * 16;
                float tot = (sq[ai][m][0] + sq[ai][m][1]) + (sq[ai][m][2] + sq[ai][m][3]); tot += __shfl_xor(tot, 16); tot += __shfl_xor(tot, 32);
                const float rs = __builtin_amdgcn_rsqf(tot * (1.0f / 1024.0f) + eps);
                bf16_t* rowp = H + (size_t)r * ldh + col0;
#pragma unroll
                for (int bj = 0; bj < 2; ++bj) { f32x4 v0 = acc[ai][bj][m][0] * rs, v1 = acc[ai][bj][m][1] * rs;
#pragma unroll
                    for (int j = 0; j < 4; ++j) { v0[j] = fmaxf(v0[j], 0.f); v0[j] *= v0[j]; v1[j] = fmaxf(v1[j], 0.f); v1[j] *= v1[j]; }
                    u32x4 w; w.x = cvt_pk_bf16(v0[0], v0[1]); w.y = cvt_pk_bf16(v0[2], v0[3]); w.z = cvt_pk_bf16(v1[0], v1[1]); w.w = cvt_pk_bf16(v1[2], v1[3]);
                    *(u32x4*)(rowp + bj * HALF) = w; } }
    }
};


struct EpiMerge2 {
    static constexpr bool PERM = true, AFTER_DRAIN = false; static constexpr int MIDK = 16, MIDSTEP = 16;
    const bf16_t* SG; bf16_t* O; int ld;
    __device__ __forceinline__ void mid(f32x4 (&acc)[2][2][4][2], const Unit& u, int t, int wr, int wc, int fr, int fq) const {
        int frv = fr, fqv = fq; asm volatile("" : "+v"(frv), "+v"(fqv));
        const int row0 = u.pm * BM + wr * 64 + frv, col0 = u.pn * BM + wc * 32 + 8 * fqv;
#pragma unroll
        for (int ai = 0; ai < 2; ++ai)
#pragma unroll
            for (int m = 0; m < 4; ++m) { const size_t ro = (size_t)(row0 + ai * HALF + m * 16) * ld + col0;
#pragma unroll
                for (int bj = 0; bj < 2; ++bj) { const u32x4 a = *(const u32x4*)(SG + ro + bj * HALF), b = *(const u32x4*)(SG + ro + bj * HALF + 1024);
                    f32x4& v0 = acc[ai][bj][m][0]; f32x4& v1 = acc[ai][bj][m][1];
                    v0[0] *= bf_lo(a.x) * __builtin_amdgcn_rcpf(bf_lo(b.x)); v0[1] *= bf_hi(a.x) * __builtin_amdgcn_rcpf(bf_hi(b.x));
                    v0[2] *= bf_lo(a.y) * __builtin_amdgcn_rcpf(bf_lo(b.y)); v0[3] *= bf_hi(a.y) * __builtin_amdgcn_rcpf(bf_hi(b.y));
                    v1[0] *= bf_lo(a.z) * __builtin_amdgcn_rcpf(bf_lo(b.z)); v1[1] *= bf_hi(a.z) * __builtin_amdgcn_rcpf(bf_hi(b.z));
                    v1[2] *= bf_lo(a.w) * __builtin_amdgcn_rcpf(bf_lo(b.w)); v1[3] *= bf_hi(a.w) * __builtin_amdgcn_rcpf(bf_hi(b.w)); } }
    }
    __device__ __forceinline__ void operator()(const f32x4 (&acc)[2][2][4][2], const Unit& u, int wr, int wc, int fr, int fq) const {
        const int row0 = u.pm * BM + wr * 64 + fr, col0 = u.pn * BM + wc * 32 + 8 * fq;
        u32x4 sb[2][4][2];
#pragma unroll
        for (int ai = 0; ai < 2; ++ai)
#pragma unroll
            for (int m = 0; m < 4; ++m)
#pragma unroll
                for (int bj = 0; bj < 2; ++bj) sb[ai][m][bj] = *(const u32x4*)(SG + (size_t)(row0 + ai * HALF + m * 16) * ld + col0 + bj * HALF + 1024);
#pragma unroll
        for (int ai = 0; ai < 2; ++ai)
#pragma unroll
            for (int m = 0; m < 4; ++m) { const size_t ro = (size_t)(row0 + ai * HALF + m * 16) * ld + col0;
#pragma unroll
                for (int bj = 0; bj < 2; ++bj) { const size_t off = ro + bj * HALF;
                    const u32x4 s = sb[ai][m][bj];
                    f32x4 v0 = acc[ai][bj][m][0], v1 = acc[ai][bj][m][1];
                    v0[0] *= bf_lo(s.x); v0[1] *= bf_hi(s.x); v0[2] *= bf_lo(s.y); v0[3] *= bf_hi(s.y);
                    v1[0] *= bf_lo(s.z); v1[1] *= bf_hi(s.z); v1[2] *= bf_lo(s.w); v1[3] *= bf_hi(s.w);
                    u32x4 w; w.x = cvt_pk_bf16(v0[0], v0[1]); w.y = cvt_pk_bf16(v0[2], v0[3]); w.z = cvt_pk_bf16(v1[0], v1[1]); w.w = cvt_pk_bf16(v1[2], v1[3]);
                    *(u32x4*)(O + off) = w; } }
    }
};

struct EpiResB {
    static constexpr bool PERM = false, AFTER_DRAIN = false; static constexpr int MIDK = 0, MIDSTEP = 0;
    const bf16_t* X1b; int lda1; float* X2; float* SQ;
    __device__ __forceinline__ void operator()(const f32x4 (&acc)[2][2][4][2], const Unit& u, int wr, int wc, int fr, int fq) const {
        const int row0 = u.pm * BM + wr * 64 + fr, col0 = u.pn * BM + wc * 32 + 4 * fq;
        u32x2 xb[2][4][2][2];
#pragma unroll
        for (int ai = 0; ai < 2; ++ai)
#pragma unroll
            for (int m = 0; m < 4; ++m)
#pragma unroll
                for (int bj = 0; bj < 2; ++bj)
#pragma unroll
                    for (int n = 0; n < 2; ++n) xb[ai][m][bj][n] = *(const u32x2*)(X1b + (size_t)(row0 + ai * HALF + m * 16) * lda1 + col0 + bj * HALF + n * 16);
#pragma unroll
        for (int ai = 0; ai < 2; ++ai)
#pragma unroll
            for (int m = 0; m < 4; ++m) { const int r = row0 + ai * HALF + m * 16; float ss = 0.f;
#pragma unroll
                for (int bj = 0; bj < 2; ++bj)
#pragma unroll
                    for (int n = 0; n < 2; ++n) { const int c = col0 + bj * HALF + n * 16; const u32x2 b2 = xb[ai][m][bj][n];
                        const f32x4 xv = {bf_lo(b2.x), bf_hi(b2.x), bf_lo(b2.y), bf_hi(b2.y)}; const f32x4 o = xv + acc[ai][bj][m][n];
                        *(f32x4*)(X2 + (size_t)r * 1024 + c) = o; ss += (o[0] * o[0] + o[1] * o[1]) + (o[2] * o[2] + o[3] * o[3]); }
                ss += __shfl_xor(ss, 16); ss += __shfl_xor(ss, 32);
                if (fq == 0) SQ[(size_t)r * 16 + u.pn * 4 + wc] = ss; }
    }
};
template <class Epi, class Sched, bool ALIGN_EPI = false, bool SP2 = false>
__device__ __forceinline__ void gemm_phase(PG8_LAS unsigned char* lds, const Gemm g, const Sched& S, const Epi& E) {
    const int tid = threadIdx.x, wid = __builtin_amdgcn_readfirstlane(tid >> 6), lane = tid & 63, wr = wid >> 2, wc = wid & 3, fr = lane & 15, fq = lane >> 4;
    const int K = g.K, nt = K / BK;
    unsigned voffA[2], voffB[2];
#pragma unroll
    for (int i = 0; i < 2; ++i) { int R, C; stage_rc(tid * 16 + i * 8192, R, C); const int Rb = Epi::PERM ? ((R & ~31) + perm32(R & 31)) : R;
        voffA[i] = (unsigned)(R * g.lda + C) * 2u; voffB[i] = (unsigned)(Rb * g.ldb + C) * 2u; }
    const size_t kstep = (size_t)(BK * 2);
    const size_t hstepA = (size_t)HALF * g.lda * 2, hstepB = (size_t)HALF * g.ldb * 2;
    const size_t tstepA = 2 * hstepA, tstepB = 2 * hstepB;
    const unsigned ldsw = (unsigned)wid * 1024u;
    const int aoff = lds_byte(wr * 64 + fr, fq * 8), boff = lds_byte(wc * 32 + fr, fq * 8);
#define PG8_SA(b, h) (((b) * 2 + (h)) * HTB)
#define PG8_SB(b, h) ((4 + (b) * 2 + (h)) * HTB)
#define PG8_STAGE(bufoff, gbase, voff) do { _Pragma("unroll") for (int _i = 0; _i < 2; ++_i) \
        __builtin_amdgcn_global_load_lds((const unsigned*)((const char*)(gbase) + (voff)[_i]), (PG8_LAS unsigned*)(lds + (bufoff) + ldsw + _i * 8192), 16, 0, 0); } while (0)
#define PG8_LDA(dst, b, h) do { _Pragma("unroll") for (int m = 0; m < 4; ++m) _Pragma("unroll") for (int k = 0; k < 2; ++k) dst[m][k] = *(const PG8_LAS bf16x8*)(lds + PG8_SA(b, h) + aoff + m * 2048 + k * 1024); } while (0)
#define PG8_LDB(dst, b, h) do { _Pragma("unroll") for (int n = 0; n < 2; ++n) _Pragma("unroll") for (int k = 0; k < 2; ++k) dst[n][k] = *(const PG8_LAS bf16x8*)(lds + PG8_SB(b, h) + boff + n * 2048 + k * 1024); } while (0)
#define PG8_MMA(ai, bj, At, Bt) do { __builtin_amdgcn_s_setprio(1); _Pragma("unroll") for (int m = 0; m < 4; ++m) _Pragma("unroll") for (int n = 0; n < 2; ++n) _Pragma("unroll") for (int k = 0; k < 2; ++k) \
        acc[ai][bj][m][n] = __builtin_amdgcn_mfma_f32_16x16x32_bf16(Bt[n][k], At[m][k], acc[ai][bj][m][n], 0, 0, 0); __builtin_amdgcn_s_setprio(0); } while (0)
#define PG8_WAIT_V(n) asm volatile("s_waitcnt vmcnt(" #n ")" ::: "memory")
#define PG8_WAIT_L(n) asm volatile("s_waitcnt lgkmcnt(" #n ")" ::: "memory")
#define PG8_BAR __builtin_amdgcn_s_barrier()
#define PG8_SCHED __builtin_amdgcn_sched_barrier(0)
    Unit cur, nxt; int ui = 0;
    if (!S.next(0, cur)) return;
    f32x4 acc[2][2][4][2];
#pragma unroll
    for (int a = 0; a < 2; ++a)
#pragma unroll
        for (int b = 0; b < 2; ++b)
#pragma unroll
            for (int m = 0; m < 4; ++m)
#pragma unroll
                for (int n = 0; n < 2; ++n) acc[a][b][m][n] = (f32x4){0.f, 0.f, 0.f, 0.f};
    bf16x8 At[4][2], B0[2][2], B1[2][2];
    const char* cA = (const char*)g.A + (size_t)cur.pm * tstepA; const char* cB = (const char*)g.Bt + (size_t)cur.pn * tstepB;
    S.a_ready(cur);
    if constexpr (SP2) {
        PG8_STAGE(PG8_SB(0, 0), cB, voffB); PG8_STAGE(PG8_SB(0, 1), cB + hstepB, voffB); PG8_STAGE(PG8_SA(0, 0), cA, voffA); PG8_STAGE(PG8_SA(0, 1), cA + hstepA, voffA);
        if (wr == 1) PG8_BAR;
        PG8_WAIT_V(2); PG8_BAR;
        PG8_STAGE(PG8_SB(1, 0), cB + kstep, voffB); PG8_STAGE(PG8_SA(1, 0), cA + kstep, voffA); PG8_STAGE(PG8_SB(1, 1), cB + hstepB + kstep, voffB);
        PG8_WAIT_V(6); PG8_BAR;
    } else {
        PG8_STAGE(PG8_SB(0, 0), cB, voffB); PG8_STAGE(PG8_SA(0, 0), cA, voffA); PG8_STAGE(PG8_SB(0, 1), cB + hstepB, voffB); PG8_STAGE(PG8_SA(0, 1), cA + hstepA, voffA);
        if (wr == 1) PG8_BAR;
        PG8_WAIT_V(4); PG8_BAR;
        PG8_STAGE(PG8_SB(1, 0), cB + kstep, voffB); PG8_STAGE(PG8_SA(1, 0), cA + kstep, voffA); PG8_STAGE(PG8_SB(1, 1), cB + hstepB + kstep, voffB);
        PG8_WAIT_V(6); PG8_BAR;
    }
    for (;;) {
        const bool has_next = S.next(ui + 1, nxt);
        const char* nA = has_next ? (const char*)g.A + (size_t)nxt.pm * tstepA : cA; const char* nB = has_next ? (const char*)g.Bt + (size_t)nxt.pn * tstepB : cB;
        for (int t = 0; t < nt; t += 2) {
            if constexpr (Epi::MIDK > 0) { if (t > 0 && t <= Epi::MIDK && (t % Epi::MIDSTEP) == 0) E.mid(acc, cur, t, wr, wc, fr, fq); }
            const bool last = (t == nt - 2);
            const char* a1 = cA + (size_t)(t + 1) * kstep;
            const char* a2 = last ? nA : cA + (size_t)(t + 2) * kstep; const char* b2 = last ? nB : cB + (size_t)(t + 2) * kstep;
            const char* a3 = a2 + kstep; const char* b3 = b2 + kstep;
            if (last && has_next) S.a_ready(nxt);
            if constexpr (SP2) {
            PG8_LDB(B0, 0, 0); PG8_LDB(B1, 0, 1); PG8_SCHED; PG8_LDA(At, 0, 0); PG8_STAGE(PG8_SA(1, 1), a1 + hstepA, voffA);
            PG8_WAIT_V(8); PG8_WAIT_L(0); PG8_BAR; PG8_MMA(0, 0, At, B0); PG8_MMA(0, 1, At, B1); PG8_BAR; PG8_SCHED;
            PG8_LDA(At, 0, 1); PG8_STAGE(PG8_SB(0, 0), b2, voffB); PG8_STAGE(PG8_SB(0, 1), b2 + hstepB, voffB); PG8_STAGE(PG8_SA(0, 0), a2, voffA);
            PG8_WAIT_V(8); PG8_WAIT_L(0); PG8_BAR; PG8_MMA(1, 0, At, B0); PG8_MMA(1, 1, At, B1); PG8_BAR; PG8_SCHED;
            PG8_LDB(B0, 1, 0); PG8_LDB(B1, 1, 1); PG8_SCHED; PG8_LDA(At, 1, 0); PG8_STAGE(PG8_SA(0, 1), a2 + hstepA, voffA);
            PG8_WAIT_V(8); PG8_WAIT_L(0); PG8_BAR; PG8_MMA(0, 0, At, B0); PG8_MMA(0, 1, At, B1); PG8_BAR; PG8_SCHED;
            PG8_LDA(At, 1, 1); PG8_STAGE(PG8_SB(1, 0), b3, voffB); PG8_STAGE(PG8_SB(1, 1), b3 + hstepB, voffB); PG8_STAGE(PG8_SA(1, 0), a3, voffA);
            PG8_WAIT_V(8); PG8_WAIT_L(0); PG8_BAR; PG8_MMA(1, 0, At, B0); PG8_MMA(1, 1, At, B1); PG8_BAR; PG8_SCHED;
            } else {
            PG8_LDB(B0, 0, 0); PG8_SCHED; PG8_LDA(At, 0, 0); PG8_STAGE(PG8_SA(1, 1), a1 + hstepA, voffA);
            PG8_WAIT_L(8); PG8_BAR; PG8_WAIT_L(0); PG8_MMA(0, 0, At, B0); PG8_BAR; PG8_SCHED;
            PG8_LDB(B1, 0, 1); PG8_STAGE(PG8_SB(0, 0), b2, voffB);
            PG8_BAR; PG8_WAIT_L(0); PG8_MMA(0, 1, At, B1); PG8_BAR;
            PG8_LDA(At, 0, 1); PG8_STAGE(PG8_SA(0, 0), a2, voffA);
            PG8_BAR; PG8_WAIT_L(0); PG8_MMA(1, 0, At, B0); PG8_BAR; PG8_SCHED;
            PG8_STAGE(PG8_SB(0, 1), b2 + hstepB, voffB);
            PG8_WAIT_V(6); PG8_BAR; PG8_MMA(1, 1, At, B1); PG8_BAR;
            PG8_LDB(B0, 1, 0); PG8_SCHED; PG8_LDA(At, 1, 0); PG8_STAGE(PG8_SA(0, 1), a2 + hstepA, voffA);
            PG8_WAIT_L(8); PG8_BAR; PG8_WAIT_L(0); PG8_MMA(0, 0, At, B0); PG8_BAR; PG8_SCHED;
            PG8_LDB(B1, 1, 1); PG8_STAGE(PG8_SB(1, 0), b3, voffB);
            PG8_BAR; PG8_WAIT_L(0); PG8_MMA(0, 1, At, B1); PG8_BAR;
            PG8_LDA(At, 1, 1); PG8_STAGE(PG8_SA(1, 0), a3, voffA);
            PG8_BAR; PG8_WAIT_L(0); PG8_MMA(1, 0, At, B0); PG8_BAR; PG8_SCHED;
            PG8_STAGE(PG8_SB(1, 1), b3 + hstepB, voffB);
            PG8_WAIT_V(6); PG8_BAR; PG8_MMA(1, 1, At, B1); PG8_BAR;
            }
        }
        if constexpr (ALIGN_EPI) { if (wr == 0) PG8_BAR; }
        if constexpr (!Epi::AFTER_DRAIN) { E(acc, cur, wr, wc, fr, fq); S.done(cur); }
        if (!has_next) break;
#pragma unroll
        for (int a = 0; a < 2; ++a)
#pragma unroll
            for (int b = 0; b < 2; ++b)
#pragma unroll
                for (int m = 0; m < 4; ++m)
#pragma unroll
                    for (int n = 0; n < 2; ++n) acc[a][b][m][n] = (f32x4){0.f, 0.f, 0.f, 0.f};
        cur = nxt; cA = nA; cB = nB; ++ui;
        if constexpr (ALIGN_EPI) { if (wr == 1) PG8_BAR; }
    }
    PG8_WAIT_V(0);
    if constexpr (!ALIGN_EPI) { if (wr == 0) PG8_BAR; }
    PG8_BAR;
    if constexpr (Epi::AFTER_DRAIN) { E.fused(acc, cur, wr, wc, fr, fq, lds, wid, lane); S.done(cur); }
#undef PG8_SA
#undef PG8_SB
#undef PG8_STAGE
#undef PG8_LDA
#undef PG8_LDB
#undef PG8_MMA
#undef PG8_WAIT_V
#undef PG8_WAIT_L
#undef PG8_BAR
#undef PG8_SCHED
}
}

constexpr int NWAVES = 8;
constexpr int BATCH = 16, SEQ = 2048, D = 1024, M = BATCH * SEQ, FF = 4096;
constexpr int LDP = 6656;
constexpr int C_Q = 0, C_K = 512, C_OG = 1024, C_GV = 2048, C_RV = 3072, C_RR = 4096, C_RK = 5120, C_WL = 6144, C_AL = 6208, C_GL = 6272, C_GAL = 6400, NA_VALID = 6416, NA = 6656, NG = 2048;
constexpr int C_MIX = 0, C_A2 = 1024, C_H = 2048, C_SG = 4096;
constexpr float NORM_EPS = 1e-6f, GLA_NORM_EPS = 1e-5f, RWKV_GN_EPS = 64e-5f;

constexpr size_t MiB = 1u << 20;
constexpr size_t WS_CTL = 0, CTL_ZERO_BYTES = 32768;
constexpr size_t WS_WIN = 2 * MiB;
constexpr size_t WS_WBR = 20 * MiB;
constexpr size_t WS_WOUT = 24 * MiB;
constexpr size_t WS_WUP = 26 * MiB;
constexpr size_t WS_WDN = 34 * MiB;
constexpr size_t WS_LW = 42 * MiB;
constexpr size_t WS_LA = WS_LW + 131072;
constexpr size_t WS_LG = WS_LA + 131072;
constexpr size_t WS_GS = 43 * MiB;
constexpr size_t WS_SQ1 = 45 * MiB;
constexpr size_t WS_SQ2 = 47 * MiB;
constexpr size_t WS_P = 64 * MiB;
constexpr size_t WS_LIN = WS_P + (size_t)M * LDP * 2;
constexpr size_t WS_END = WS_LIN + (size_t)M * 256 * 2;
static_assert(WS_END <= 512 * MiB, "d_ws map");
constexpr int CW_BAR = 4096;
constexpr int CW_PAN = 16384;

constexpr int LDS_BYTES = 160 * 1024;
constexpr int MISC_OFF = LDS_BYTES - 256;

#define GAS __attribute__((address_space(1)))
#define LAS __attribute__((address_space(3)))
typedef unsigned short bf16;
typedef unsigned v4u __attribute__((ext_vector_type(4)));
typedef unsigned v2u __attribute__((ext_vector_type(2)));
typedef float f32x4 __attribute__((ext_vector_type(4)));
typedef short bf16x8 __attribute__((ext_vector_type(8)));
typedef GAS unsigned gu32;
#define RLX_AGENT __ATOMIC_RELAXED, __HIP_MEMORY_SCOPE_AGENT
#define LDS_WAIT() asm volatile("s_waitcnt lgkmcnt(0)" ::: "memory")
#define VM_WAIT() asm volatile("s_waitcnt vmcnt(0)" ::: "memory")
__device__ __forceinline__ unsigned f2bf(float f) { unsigned u = __builtin_bit_cast(unsigned, f); return (u + 0x7fffu + ((u >> 16) & 1u)) >> 16; }
typedef float f32x2_t __attribute__((ext_vector_type(2))); typedef __bf16 bf16x2_t __attribute__((ext_vector_type(2)));
__device__ __forceinline__ unsigned pk2(float lo, float hi) { const f32x2_t v = {lo, hi}; return __builtin_bit_cast(unsigned, __builtin_convertvector(v, bf16x2_t)); }
__device__ __forceinline__ float bflo(unsigned w) { return __uint_as_float(w << 16); }
__device__ __forceinline__ float bfhi(unsigned w) { return __uint_as_float(w & 0xffff0000u); }
__device__ __forceinline__ void unpack8(const v4u w, float (&o)[8]) { o[0] = bflo(w.x); o[1] = bfhi(w.x); o[2] = bflo(w.y); o[3] = bfhi(w.y); o[4] = bflo(w.z); o[5] = bfhi(w.z); o[6] = bflo(w.w); o[7] = bfhi(w.w); }
__device__ __forceinline__ v4u pack8(const float (&v)[8]) { v4u w; w.x = pk2(v[0], v[1]); w.y = pk2(v[2], v[3]); w.z = pk2(v[4], v[5]); w.w = pk2(v[6], v[7]); return w; }
__device__ __forceinline__ float fexp(float x) { return __builtin_amdgcn_exp2f(1.4426950408889634f * x); }
__device__ __forceinline__ float fsig(float x) { return __builtin_amdgcn_rcpf(1.0f + fexp(-x)); }
__device__ __forceinline__ float fsoftplus(float x) { return fmaxf(x, 0.f) + __logf(1.0f + fexp(-fabsf(x))); }
__device__ __forceinline__ float add8(float x) {
    x += __int_as_float(__builtin_amdgcn_update_dpp(0, __float_as_int(x), 0xB1, 0xf, 0xf, false));
    x += __int_as_float(__builtin_amdgcn_update_dpp(0, __float_as_int(x), 0x4E, 0xf, 0xf, false));
    x += __int_as_float(__builtin_amdgcn_update_dpp(0, __float_as_int(x), 0x141, 0xf, 0xf, false));
    return x;
}
__device__ __forceinline__ bf16x8 lfrag(const LAS bf16* base, int ld, int r0, int k0, int lane) { return *(const LAS bf16x8*)(base + (r0 + (lane & 15)) * ld + k0 + 8 * (lane >> 4)); }
__device__ __forceinline__ bf16x8 gfrag(const bf16* base, int ld, int r0, int k0, int lane) { return *(const bf16x8*)(base + (size_t)(r0 + (lane & 15)) * ld + k0 + 8 * (lane >> 4)); }
#define MFMA16(a, b, c) __builtin_amdgcn_mfma_f32_16x16x32_bf16((a), (b), (c), 0, 0, 0)

#define XB_TMO      128
#define XB_XCNT(j)  (256  + 64 * (j))
#define XB_XSUB(j)  (1280 + 64 * (j))
#define XB_XGEN(j)  (2304 + 64 * (j))
#define XB_TOP      3328
#define XB_TOPGEN   3392
#define XCD_BAR_WORDS 3456
#define XB_SPIN_CAP (1u << 18)

__device__ __forceinline__ unsigned xb_ld(unsigned* p)              { return __hip_atomic_load(p, __ATOMIC_RELAXED, __HIP_MEMORY_SCOPE_AGENT); }
__device__ __forceinline__ unsigned xb_add(unsigned* p, unsigned v) { return __hip_atomic_fetch_add(p, v, __ATOMIC_RELAXED, __HIP_MEMORY_SCOPE_AGENT); }
__device__ __forceinline__ unsigned xb_xcc_id() { return (unsigned)__builtin_amdgcn_s_getreg((3 << 11) | 20) & 0xFu; }
#define XB_SPIN(cond, bar) do { unsigned _sp = 0; while (cond) { __builtin_amdgcn_s_sleep(1); \
    if ((++_sp & 255u) == 0u) { if (xb_ld(&(bar)[XB_TMO])) break; if (_sp > XB_SPIN_CAP) { atomicAdd(&(bar)[XB_TMO], 1u); break; } } } } while (0)

struct XcdBarrier {
    unsigned* bar; unsigned x;
    volatile LAS unsigned* st;
};

__device__ __forceinline__ XcdBarrier xcd_barrier_post(unsigned* bar, volatile LAS unsigned* st) {
    XcdBarrier b; b.bar = bar; b.x = xb_xcc_id(); b.st = st;
    if (threadIdx.x == 0) (void)xb_add(&bar[XB_XCNT(b.x)], 1u);
    return b;
}
__device__ __forceinline__ void xcd_barrier_complete(unsigned* bar, unsigned x, unsigned& nloc, unsigned& nx) {
    const unsigned G = gridDim.x * gridDim.y * gridDim.z;
    unsigned sum, cnt, mine, sp = 0u;
    for (;;) {
        sum = 0u; cnt = 0u; mine = 0u;
#pragma unroll
        for (unsigned j = 0; j < 16; ++j) { const unsigned c = xb_ld(&bar[XB_XCNT(j)]); sum += c; cnt += (c > 0u) ? 1u : 0u; mine = (j == x) ? c : mine; }
        if (sum == G) break;
        __builtin_amdgcn_s_sleep(1);
        if ((++sp & 255u) == 0u) { if (xb_ld(&bar[XB_TMO])) break; if (sp > XB_SPIN_CAP) { atomicAdd(&bar[XB_TMO], 1u); break; } }
    }
    nloc = mine > 0u ? mine : 1u; nx = cnt > 0u ? cnt : 1u;
}

__device__ __forceinline__ void xcd_barrier(const XcdBarrier& b) {
    asm volatile("s_waitcnt vmcnt(0)" ::: "memory");
    __syncthreads();
    if (threadIdx.x == 0) {
        unsigned* bar = b.bar;
        __builtin_amdgcn_s_waitcnt(0);
        unsigned nloc = b.st[0], nx = b.st[1];
        if (nloc == 0u) { xcd_barrier_complete(bar, b.x, nloc, nx); b.st[0] = nloc; b.st[1] = nx; }
        const unsigned old = xb_add(&bar[XB_XSUB(b.x)], 1u);
        const unsigned gen = old / nloc;
        if (old + 1u == (gen + 1u) * nloc) {
            __builtin_amdgcn_fence(__ATOMIC_RELEASE, "agent");
            asm volatile("s_waitcnt vmcnt(0)" ::: "memory");
            const unsigned og = xb_add(&bar[XB_TOP], 1u);
            const unsigned tg = og / nx;
            if (og + 1u == (tg + 1u) * nx) xb_add(&bar[XB_TOPGEN], 1u);
            else XB_SPIN(xb_ld(&bar[XB_TOPGEN]) == tg, bar);
            __builtin_amdgcn_fence(__ATOMIC_ACQUIRE, "agent");
            xb_add(&bar[XB_XGEN(b.x)], 1u);
            asm volatile("s_waitcnt vmcnt(0)" ::: "memory");
        } else {
            XB_SPIN(xb_ld(&bar[XB_XGEN(b.x)]) == gen, bar);
            __builtin_amdgcn_fence(__ATOMIC_ACQUIRE, "agent");
            asm volatile("s_waitcnt vmcnt(0)" ::: "memory");
        }
    }
    __syncthreads();
}

struct Frame {
    LAS unsigned char* lds;
    volatile LAS unsigned* MISC;
    gu32* ctl;
    int tid, lane, wave;
    int vcu, G;
    const float* in[24]; float* out;
    bf16 *WIN, *WBR, *WOUT, *WUP, *WDN, *LW, *LA, *LG, *P, *XN, *LIN;
    float *GS, *SQ1, *SQ2;
};
enum { I_X = 0, I_NORM_MIX, I_W_IN, I_GLA_A_W2, I_GLA_A_B, I_GLA_NORM, I_MU, I_W0, I_W_W2, I_A0, I_A_W2, I_G_W2, I_K_K, I_K_A, I_R_K, I_LN_W, I_LN_B, I_WB_GLA, I_WB_RWKV, I_W_OUT, I_NORM_MLP, I_W_UP, I_W_DOWN, I_NORM_FINAL };

__device__ __forceinline__ float wave_sum(float v) {
#pragma unroll
    for (int o = 1; o < 64; o <<= 1) v += __shfl_xor(v, o);
    return v;
}
__device__ __forceinline__ int win_src_col(int n) {
    if (n < 1024) return n;
    if (n < 2048) return n + 1024;
    if (n < 3072) return n - 1024;
    if (n < 4096) return n - 3072 + 5136;
    if (n < 6144) return n - 4096 + 3088;
    if (n < 6400) return n - 6144 + 6160;
    if (n < 6416) return n - 6400 + 3072;
    if (n < 6656) return -1;
    return n - 6656 + 6416;
}
__device__ __forceinline__ void tr_item(const float* W, int Nsrc, int sc4, int k0, const float* gk, bf16* WT, int ldk, int drow, int dk0, LAS float* scr, int lane) {
    const int r8 = lane >> 3, c4 = (lane & 7) * 4;
    f32x4 v[8];
#pragma unroll
    for (int i = 0; i < 8; ++i) { const int kk = 8 * i + r8;
        v[i] = (sc4 >= 0) ? *(const f32x4*)(W + (size_t)(k0 + kk) * Nsrc + sc4) : (f32x4){0.f, 0.f, 0.f, 0.f}; }
#pragma unroll
    for (int i = 0; i < 8; ++i) { const int kk = 8 * i + r8; f32x4 x = v[i]; if (gk) x = x * gk[k0 + kk];
        scr[kk * 33 + c4] = x[0]; scr[kk * 33 + c4 + 1] = x[1]; scr[kk * 33 + c4 + 2] = x[2]; scr[kk * 33 + c4 + 3] = x[3]; }
    LDS_WAIT(); asm volatile("" ::: "memory");
    const int c = lane & 7;
#pragma unroll
    for (int j = 0; j < 4; ++j) { const int n = (lane >> 3) + 8 * j; const LAS float* s = scr + (8 * c) * 33 + n;
        v4u o; o.x = pk2(s[0 * 33], s[1 * 33]); o.y = pk2(s[2 * 33], s[3 * 33]); o.z = pk2(s[4 * 33], s[5 * 33]); o.w = pk2(s[6 * 33], s[7 * 33]);
        *(GAS v4u*)(WT + (size_t)(drow + n) * ldk + dk0 + k0 + 8 * c) = o; }
    LDS_WAIT(); asm volatile("" ::: "memory");
}
__device__ __forceinline__ void p0_prologue(Frame& F) {
    LAS float* scr = (LAS float*)(F.lds + F.wave * 16384);
    const int gw = F.vcu * NWAVES + F.wave, NGW = F.G * NWAVES, lane = F.lane;
    constexpr int I_WIN = 16 * 272, I_B = 16 * 32, I_UP = 16 * 128, I_DN = 64 * 32, I_L64 = 32, I_L128 = 64;
    constexpr int NITEMS = I_WIN + 3 * I_B + I_UP + I_DN + 2 * I_L64 + I_L128;
    for (int it = gw; it < NITEMS; it += NGW) {
        int r = it;
        if (r < I_WIN) { const int kb = r / 272, nb = r % 272; tr_item(F.in[I_W_IN], 8464, win_src_col(32 * nb + ((lane & 7) * 4)), 64 * kb, nullptr, F.WIN, 1024, 32 * nb, 0, scr, lane); continue; } r -= I_WIN;
        if (r < I_B) { const int kb = r / 32, nb = r % 32; tr_item(F.in[I_WB_GLA], 1024, 32 * nb + ((lane & 7) * 4), 64 * kb, nullptr, F.WBR, 2048, 32 * nb, 0, scr, lane); continue; } r -= I_B;
        if (r < I_B) { const int kb = r / 32, nb = r % 32; tr_item(F.in[I_WB_RWKV], 1024, 32 * nb + ((lane & 7) * 4), 64 * kb, nullptr, F.WBR, 2048, 32 * nb, 1024, scr, lane); continue; } r -= I_B;
        if (r < I_B) { const int kb = r / 32, nb = r % 32; tr_item(F.in[I_W_OUT], 1024, 32 * nb + ((lane & 7) * 4), 64 * kb, nullptr, F.WOUT, 1024, 32 * nb, 0, scr, lane); continue; } r -= I_B;
        if (r < I_UP) { const int kb = r / 128, nb = r % 128; tr_item(F.in[I_W_UP], 4096, 32 * nb + ((lane & 7) * 4), 64 * kb, F.in[I_NORM_MLP], F.WUP, 1024, 32 * nb, 0, scr, lane); continue; } r -= I_UP;
        if (r < I_DN) { const int kb = r / 32, nb = r % 32; tr_item(F.in[I_W_DOWN], 1024, 32 * nb + ((lane & 7) * 4), 64 * kb, nullptr, F.WDN, 4096, 32 * nb, 0, scr, lane); continue; } r -= I_DN;
        if (r < I_L64) { tr_item(F.in[I_W_W2], 1024, 32 * r + ((lane & 7) * 4), 0, nullptr, F.LW, 64, 32 * r, 0, scr, lane); continue; } r -= I_L64;
        if (r < I_L64) { tr_item(F.in[I_A_W2], 1024, 32 * r + ((lane & 7) * 4), 0, nullptr, F.LA, 64, 32 * r, 0, scr, lane); continue; } r -= I_L64;
        { const int kb = r / 32, nb = r % 32; tr_item(F.in[I_G_W2], 1024, 32 * nb + ((lane & 7) * 4), 64 * kb, nullptr, F.LG, 128, 32 * nb, 0, scr, lane); }
    }
    const float* x = F.in[I_X]; const float* g = F.in[I_NORM_MIX];
    f32x4 gv[4];
#pragma unroll
    for (int j = 0; j < 4; ++j) gv[j] = ((const f32x4*)g)[lane + 64 * j];
    for (int m = gw; m < M; m += 4 * NGW) {
        f32x4 v[4][4]; float ss[4];
#pragma unroll
        for (int u = 0; u < 4; ++u) { const GAS f32x4* xr = (const GAS f32x4*)(x + (size_t)(m + u * NGW) * D) + lane;
#pragma unroll
            for (int j = 0; j < 4; ++j) v[u][j] = xr[64 * j]; }
#pragma unroll
        for (int u = 0; u < 4; ++u) { float s0 = 0.f;
#pragma unroll
            for (int j = 0; j < 4; ++j) s0 += (v[u][j].x * v[u][j].x + v[u][j].y * v[u][j].y) + (v[u][j].z * v[u][j].z + v[u][j].w * v[u][j].w);
            ss[u] = s0; }
#pragma unroll
        for (int o = 1; o < 64; o <<= 1) {
#pragma unroll
            for (int u = 0; u < 4; ++u) ss[u] += __shfl_xor(ss[u], o); }
#pragma unroll
        for (int u = 0; u < 4; ++u) { const float rs = __builtin_amdgcn_rsqf(ss[u] * (1.f / D) + NORM_EPS);
            GAS v2u* o8 = (GAS v2u*)(F.XN + (size_t)(m + u * NGW) * D) + lane;
#pragma unroll
            for (int j = 0; j < 4; ++j) { v2u w; w.x = pk2(v[u][j].x * rs * gv[j].x, v[u][j].y * rs * gv[j].y); w.y = pk2(v[u][j].z * rs * gv[j].z, v[u][j].w * rs * gv[j].w); o8[64 * j] = w; } }
    }
}

__device__ __forceinline__ bf16x8 dfrag(const f32x4 d) {
    const unsigned lo = pk2(d[0], d[1]), hi = pk2(d[2], d[3]); v4u w = {lo, hi, 0u, 0u}; return __builtin_bit_cast(bf16x8, w); }
__device__ __forceinline__ bf16x8 dfrag2(const f32x4 d0, const f32x4 d1) {
    v4u w = {pk2(d0[0], d0[1]), pk2(d0[2], d0[3]), pk2(d1[0], d1[1]), pk2(d1[2], d1[3])}; return __builtin_bit_cast(bf16x8, w); }
__device__ __forceinline__ bf16x8 pfrag(const LAS bf16* base, int ld, int row0, int col0, int col1, int lane) {
    const LAS bf16* p = base + (row0 + (lane & 15)) * ld + 4 * (lane >> 4);
    const v2u a = *(const LAS v2u*)(p + col0), b = *(const LAS v2u*)(p + col1); v4u w = {a.x, a.y, b.x, b.y}; return __builtin_bit_cast(bf16x8, w); }
__device__ __forceinline__ bf16x8 pfrag1(const LAS bf16* base, int ld, int row0, int col0, int lane) {
    const v2u a = *(const LAS v2u*)(base + (row0 + (lane & 15)) * ld + 4 * (lane >> 4) + col0); v4u w = {a.x, a.y, 0u, 0u}; return __builtin_bit_cast(bf16x8, w); }
__device__ __forceinline__ float ldbf(const LAS bf16* p) { return __uint_as_float(((unsigned)*p) << 16); }


typedef short s16x4 __attribute__((ext_vector_type(4)));
__device__ __forceinline__ s16x4 trd4(const LAS bf16* img, int ld, int row, int col0, int lane) {
    const int i = lane & 15; return __builtin_amdgcn_ds_read_tr16_b64_v4i16((LAS s16x4*)(img + (row + (i >> 2)) * ld + col0 + 4 * (i & 3))); }
__device__ __forceinline__ bf16x8 trfrag(const LAS bf16* img, int ld, int rowA, int rowB, int col0, int lane) {
    const s16x4 a = trd4(img, ld, rowA, col0, lane), b = trd4(img, ld, rowB, col0, lane); return (bf16x8){a[0], a[1], a[2], a[3], b[0], b[1], b[2], b[3]}; }
__device__ __forceinline__ bf16x8 trfrag1(const LAS bf16* img, int ld, int rowA, int col0, int lane) {
    const s16x4 a = trd4(img, ld, rowA, col0, lane); return (bf16x8){a[0], a[1], a[2], a[3], 0, 0, 0, 0}; }
__device__ __forceinline__ f32x4 tr2f(const s16x4 a) { return (f32x4){__uint_as_float(((unsigned)(unsigned short)a[0]) << 16), __uint_as_float(((unsigned)(unsigned short)a[1]) << 16), __uint_as_float(((unsigned)(unsigned short)a[2]) << 16), __uint_as_float(((unsigned)(unsigned short)a[3]) << 16)}; }

__device__ __forceinline__ void rwkv_item(Frame& F, int item, bool dry = false) {
    const int b = item >> 4, h = item & 15, tid = F.tid, wave = F.wave;
    LAS unsigned char* L = F.lds;
    LAS bf16* sAt = (LAS bf16*)L; LAS bf16* sRt = sAt + 4608; LAS bf16* sBt = sRt + 4608; LAS bf16* sKt = sBt + 4608;
    LAS bf16* sBh = sKt + 4608; LAS bf16* sKh = sBh + 4608; LAS bf16* sV = sKh + 4608;
    LAS bf16* sAabT = sV + 4608; LAS bf16* sAakT = sAabT + 4608; LAS bf16* sArbT = sAakT + 4608; LAS bf16* sArkT = sArbT + 4608;
    LAS bf16* sWL = sAabT; LAS bf16* sAL = sWL + 4608; LAS bf16* sGL = sAL + 4608;
    LAS bf16* sQhT = sBt; LAS bf16* sMmT = sKt;
    LAS float* sLW = (LAS float*)(sArkT + 4608); LAS float* sY = sLW;
    LAS float* sAa = sLW + 4352; LAS float* sG = sAa + 4352;
    LAS float* sTot = sG + 4352; LAS float* sBonus = sTot + 512; LAS float* sVlast = sBonus + 64; LAS float* sGam = sVlast + 128;
    LAS float* sC = sGam + 64;
    const int t = tid >> 3, kb = tid & 7, hc0 = h * 64 + kb * 8;
    {   const float* mu = F.in[I_MU];
        if (tid < 64) { const int ch = h * 64 + tid;
            sC[tid] = mu[ch]; sC[64 + tid] = mu[1024 + ch]; sC[128 + tid] = mu[2048 + ch]; sC[192 + tid] = F.in[I_K_K][ch]; sC[256 + tid] = F.in[I_K_A][ch];
            sC[320 + tid] = F.in[I_R_K][ch]; sC[384 + tid] = F.in[I_LN_W][ch]; sC[448 + tid] = F.in[I_LN_B][ch]; sC[512 + tid] = mu[3072 + tid]; sC[576 + tid] = mu[3136 + tid]; }
        else if (tid < 192) sC[640 + tid - 64] = mu[3200 + tid - 64];
    }
    const int wci = wave & 3;
    bf16x8 fL[4];
    bf16x8 fA[2];
    if (wave < 4) { fL[0] = gfrag(F.LW, 64, h * 64 + wci * 16, 0, F.lane); fL[1] = gfrag(F.LW, 64, h * 64 + wci * 16, 32, F.lane); fL[2] = fL[0]; fL[3] = fL[0]; fA[0] = fL[0]; fA[1] = fL[0]; }
    else {
#pragma unroll
        for (int ks = 0; ks < 4; ++ks) fL[ks] = gfrag(F.LG, 128, h * 64 + wci * 16, ks * 32, F.lane);
        fA[0] = gfrag(F.LA, 64, h * 64 + wci * 16, 0, F.lane); fA[1] = gfrag(F.LA, 64, h * 64 + wci * 16, 32, F.lane); }
    const float w0c = F.in[I_W0][h * 64 + wci * 16 + (F.lane & 15)], a0c = F.in[I_A0][h * 64 + wci * 16 + (F.lane & 15)];
    f32x4 Hs[4];
#pragma unroll
    for (int i = 0; i < 4; ++i) Hs[i] = (f32x4){0.f, 0.f, 0.f, 0.f};
    LAS bf16* sEx = (LAS bf16*)(sC + 768);
    if (tid < 48) ((LAS v4u*)(sEx + 7 * 192))[tid] = (v4u){0u, 0u, 0u, 0u};
    v4u pr, pk, pv, pwl, pal, pg0, pg1;
    {   const size_t mrow = (size_t)b * SEQ + t; const bf16* row = F.P + mrow * LDP; const bf16* lin = F.LIN + mrow * 256;
        pr = *(const v4u*)(row + C_RR + hc0); pk = *(const v4u*)(row + C_RK + hc0); pv = *(const v4u*)(row + C_RV + hc0);
        pwl = *(const v4u*)(lin + kb * 8); pal = *(const v4u*)(lin + 64 + kb * 8); pg0 = *(const v4u*)(lin + 128 + kb * 8); pg1 = *(const v4u*)(lin + 192 + kb * 8); }
    __syncthreads();
    for (int c = 0; c < 32; ++c) {
        const size_t m0 = (size_t)b * SEQ + c * 64;
        int hc = hc0, lane = F.lane; asm volatile("" : "+v"(hc), "+v"(lane));
        const int c8 = hc & 63, cl = lane & 15, g4 = lane >> 4;
        const v4u cr = pr, ck = pk, cv = pv;
        *(LAS v4u*)(sWL + t * 72 + c8) = pwl; *(LAS v4u*)(sAL + t * 72 + c8) = pal; *(LAS v4u*)(sGL + t * 136 + c8) = pg0; *(LAS v4u*)(sGL + t * 136 + 64 + c8) = pg1;
        {   LAS bf16* ex = sEx + ((wave < 7) ? wave : 7 + (c & 1)) * 192;
            if ((lane >> 3) == 7) { *(LAS v4u*)(ex + c8) = cr; *(LAS v4u*)(ex + 64 + c8) = ck; *(LAS v4u*)(ex + 128 + c8) = cv; } }
        __syncthreads();
        {   const int ch = wci * 16 + cl;
            if (wave < 4) {
                f32x4 lwv[4];
#pragma unroll
                for (int ti = 0; ti < 4; ++ti) { f32x4 accw = {0.f, 0.f, 0.f, 0.f};
#pragma unroll
                    for (int ks = 0; ks < 2; ++ks) accw = MFMA16(lfrag(sWL, 72, ti * 16, ks * 32, lane), fL[ks], accw);
#pragma unroll
                    for (int j = 0; j < 4; ++j) lwv[ti][j] = -0.6065306597126334f * fsig(w0c + accw[j]); }
                float base = 0.f;
#pragma unroll
                for (int ti = 0; ti < 4; ++ti) {
                    lwv[ti][1] += lwv[ti][0]; lwv[ti][2] += lwv[ti][1]; lwv[ti][3] += lwv[ti][2];
                    const float sg = lwv[ti][3];
                    const float s0 = __shfl(sg, cl), s1 = __shfl(sg, cl + 16), s2 = __shfl(sg, cl + 32), s3 = __shfl(sg, cl + 48);
                    const float ex = base + ((g4 > 0) ? s0 : 0.f) + ((g4 > 1) ? s1 : 0.f) + ((g4 > 2) ? s2 : 0.f);
                    base += (s0 + s1) + (s2 + s3);
#pragma unroll
                    for (int j = 0; j < 4; ++j) sLW[(ti * 16 + g4 * 4 + j) * 68 + ch] = lwv[ti][j] + ex; }
            } else {
#pragma unroll
                for (int ti = 0; ti < 4; ++ti) { f32x4 accg = {0.f, 0.f, 0.f, 0.f}, acca = accg;
#pragma unroll
                    for (int ks = 0; ks < 4; ++ks) accg = MFMA16(lfrag(sGL, 136, ti * 16, ks * 32, lane), fL[ks], accg);
#pragma unroll
                    for (int ks = 0; ks < 2; ++ks) acca = MFMA16(lfrag(sAL, 72, ti * 16, ks * 32, lane), fA[ks], acca);
#pragma unroll
                    for (int j = 0; j < 4; ++j) { sG[(ti * 16 + g4 * 4 + j) * 68 + ch] = accg[j]; sAa[(ti * 16 + g4 * 4 + j) * 68 + ch] = fsig(a0c + acca[j]); } } }
        }
            float rr[8], kr[8], vr[8];
            {   const bool first = (lane >> 3) == 0;
                const LAS bf16* ex = sEx + ((wave == 0) ? (7 + ((c + 1) & 1)) : (wave - 1)) * 192;
                v4u qr, qk, qv;
                qr.x = __shfl_up(cr.x, 8); qr.y = __shfl_up(cr.y, 8); qr.z = __shfl_up(cr.z, 8); qr.w = __shfl_up(cr.w, 8);
                qk.x = __shfl_up(ck.x, 8); qk.y = __shfl_up(ck.y, 8); qk.z = __shfl_up(ck.z, 8); qk.w = __shfl_up(ck.w, 8);
                qv.x = __shfl_up(cv.x, 8); qv.y = __shfl_up(cv.y, 8); qv.z = __shfl_up(cv.z, 8); qv.w = __shfl_up(cv.w, 8);
                if (first) { qr = *(const LAS v4u*)(ex + c8); qk = *(const LAS v4u*)(ex + 64 + c8); qv = *(const LAS v4u*)(ex + 128 + c8); }
                float cu[8], pv8[8];
                unpack8(cr, cu); unpack8(qr, pv8);
#pragma unroll
                for (int j = 0; j < 8; ++j) rr[j] = cu[j] + (pv8[j] - cu[j]) * sC[c8 + j];
                unpack8(ck, cu); unpack8(qk, pv8);
#pragma unroll
                for (int j = 0; j < 8; ++j) kr[j] = cu[j] + (pv8[j] - cu[j]) * sC[64 + c8 + j];
                unpack8(cv, cu); unpack8(qv, pv8);
#pragma unroll
                for (int j = 0; j < 8; ++j) vr[j] = cu[j] + (pv8[j] - cu[j]) * sC[128 + c8 + j];
            }
            if (c < 31) { const size_t mrow = m0 + 64 + t; const bf16* row = F.P + mrow * LDP; const bf16* lin = F.LIN + mrow * 256;
                pr = *(const v4u*)(row + C_RR + hc); pk = *(const v4u*)(row + C_RK + hc); pv = *(const v4u*)(row + C_RV + hc);
                pwl = *(const v4u*)(lin + c8); pal = *(const v4u*)(lin + 64 + c8); pg0 = *(const v4u*)(lin + 128 + c8); pg1 = *(const v4u*)(lin + 192 + c8); }
            float kkr[8], ss = 0.f, bon = 0.f;
#pragma unroll
            for (int j = 0; j < 8; ++j) { kkr[j] = kr[j] * sC[192 + c8 + j]; ss += kkr[j] * kkr[j]; }
            ss = add8(ss); const float inv = __builtin_amdgcn_rsqf(fmaxf(ss, 1e-24f));
        __syncthreads();
        {
            float tot[8];
            {   const f32x4 t0 = *(const LAS f32x4*)(sLW + 63 * 68 + c8), t1 = *(const LAS f32x4*)(sLW + 63 * 68 + c8 + 4);
#pragma unroll
                for (int j = 0; j < 4; ++j) { tot[j] = t0[j]; tot[4 + j] = t1[j]; } }
            float inc[8], pl[8], av[8];
            {   const f32x4 i0 = *(const LAS f32x4*)(sLW + t * 68 + c8), i1 = *(const LAS f32x4*)(sLW + t * 68 + c8 + 4);
                const f32x4 a0 = *(const LAS f32x4*)(sAa + t * 68 + c8), a1 = *(const LAS f32x4*)(sAa + t * 68 + c8 + 4);
                f32x4 p0 = {0.f, 0.f, 0.f, 0.f}, p1 = p0;
                if (t > 0) { p0 = *(const LAS f32x4*)(sLW + (t - 1) * 68 + c8); p1 = *(const LAS f32x4*)(sLW + (t - 1) * 68 + c8 + 4); }
#pragma unroll
                for (int j = 0; j < 4; ++j) { inc[j] = i0[j]; inc[4 + j] = i1[j]; pl[j] = p0[j]; pl[4 + j] = p1[j]; av[j] = a0[j]; av[4 + j] = a1[j]; } }
            float at[8], rt[8], bt[8], kt[8], bh[8], kh[8], etot[8];
#pragma unroll
            for (int j = 0; j < 8; ++j) etot[j] = fexp(tot[j]);
#pragma unroll
            for (int j = 0; j < 8; ++j) {
                const float gg = inc[j], gp = pl[j];
                const float a = av[j], kk = kkr[j] * inv, kp = kr[j] * (1.0f + (a - 1.0f) * sC[256 + c8 + j]);
                bon += rr[j] * kp * sC[320 + c8 + j];
                const float eg = fexp(gg), egp = fexp(gp), eng = fexp(-gg), ehl = etot[j] * eng, bv = kk * a;
                at[j] = -kk * egp; rt[j] = rr[j] * eg; bt[j] = bv * eng; kt[j] = kp * eng; bh[j] = bv * ehl; kh[j] = kp * ehl;
                if (t == 0) sGam[c8 + j] = etot[j]; }
            {   LAS bf16* tb = sAt;
                *(LAS v4u*)(tb + t * 72 + c8) = pack8(at); *(LAS v4u*)(tb + 4608 + t * 72 + c8) = pack8(rt);
                *(LAS v4u*)(tb + 2 * 4608 + t * 72 + c8) = pack8(bt); *(LAS v4u*)(tb + 3 * 4608 + t * 72 + c8) = pack8(kt); }
            *(LAS v4u*)(sBh + t * 72 + c8) = pack8(bh); *(LAS v4u*)(sKh + t * 72 + c8) = pack8(kh); *(LAS v4u*)(sV + t * 72 + c8) = pack8(vr);
            bon = add8(bon); if (kb == 0) sBonus[t] = bon;
        }
        __syncthreads();
#pragma unroll
        for (int e = 0; e < 5; ++e) { const int n = wave * 5 + e, o = n / 10, p = n - 10 * o, ti = (p >= 6) ? 3 : ((p >= 3) ? 2 : ((p >= 1) ? 1 : 0)), si = p - ((ti * (ti + 1)) >> 1);
            LAS bf16* dst = sAabT + o * 4608; const LAS bf16* as = (o < 2) ? sAt : sRt; const LAS bf16* bs = (o & 1) ? sKt : sBt;
            f32x4 acc = {0.f, 0.f, 0.f, 0.f};
#pragma unroll
            for (int ks = 0; ks < 2; ++ks) acc = MFMA16(lfrag(as, 72, ti * 16, ks * 32, lane), lfrag(bs, 72, si * 16, ks * 32, lane), acc);
            const int sc = si * 16 + cl, tr0 = ti * 16 + g4 * 4, dd = tr0 - sc - ((o < 2) ? 1 : 0);
#pragma unroll
            for (int j = 0; j < 4; ++j) acc[j] = (dd + j >= 0) ? acc[j] : 0.f;
            v2u w; w.x = pk2(acc[0], acc[1]); w.y = pk2(acc[2], acc[3]);
            *(LAS v2u*)(dst + sc * 72 + tr0) = w; }
#pragma unroll
        for (int e = 0; e < 3; ++e) { const int z = wave * 3 + e, o = z / 6, p = z - 6 * o, ti = (p >= 5) ? 2 : ((p >= 3) ? 1 : 0), si = (p >= 5) ? 3 : ((p >= 3) ? p - 1 : p + 1);
            *(LAS v2u*)(sAabT + o * 4608 + (si * 16 + cl) * 72 + ti * 16 + g4 * 4) = (v2u){0u, 0u}; }
        {   const int i = wave & 3; f32x4 Pm = {0.f, 0.f, 0.f, 0.f}, Qm = Pm, TT;
#pragma unroll
            for (int ks = 0; ks < 2; ++ks) { const bf16x8 af = lfrag(sAt, 72, i * 16, ks * 32, lane), bf = lfrag(sBt, 72, i * 16, ks * 32, lane);
                Pm = MFMA16(af, bf, Pm); Qm = MFMA16(bf, af, Qm); }
#pragma unroll
            for (int j = 0; j < 4; ++j) { Pm[j] = (cl < 4 * g4 + j) ? Pm[j] : 0.f; Qm[j] = (4 * g4 + j < cl) ? Qm[j] : 0.f;
                TT[j] = Qm[j] + ((4 * g4 + j == cl) ? 1.0f : 0.f); }
            const f32x4 z4 = {0.f, 0.f, 0.f, 0.f};
#pragma unroll
            for (int lvl = 0; lvl < 3; ++lvl) { const bf16x8 pf = dfrag(Pm), qf = dfrag(Qm);
                const f32x4 Pn = MFMA16(qf, pf, z4); if (lvl < 2) Qm = MFMA16(pf, qf, z4);
                Pm = Pn; TT = MFMA16(dfrag(Pm), dfrag(TT), TT); }
            if (wave < 4) { v2u w; w.x = pk2(TT[0], TT[1]); w.y = pk2(TT[2], TT[3]); *(LAS v2u*)((LAS unsigned char*)sTot + (i * 64 + lane) * 8) = w; }
        }
        __syncthreads();
        bf16x8 TTf[4];
#pragma unroll
        for (int i = 0; i < 4; ++i) { const v2u w = *(const LAS v2u*)((LAS unsigned char*)sTot + (i * 64 + lane) * 8); v4u x = {w.x, w.y, 0u, 0u}; TTf[i] = __builtin_bit_cast(bf16x8, x); }
        f32x4 Z[4], QY[4], MN[4];
        const f32x4 zero4 = {0.f, 0.f, 0.f, 0.f};
        if (wave < 4) {
#pragma unroll
            for (int i = 0; i < 4; ++i) Z[i] = tr2f(trd4(sAt, 72, 16 * i + 4 * g4, 16 * wave, lane));
        } else { const int vt = wave - 4;
#pragma unroll
            for (int i = 0; i < 4; ++i) { Z[i] = zero4;
#pragma unroll
                for (int ks = 0; ks < 2; ++ks) Z[i] = MFMA16(trfrag(sAakT, 72, 32 * ks + 8 * g4, 32 * ks + 8 * g4 + 4, 16 * i, lane), trfrag(sV, 72, 32 * ks + 8 * g4, 32 * ks + 8 * g4 + 4, 16 * vt, lane), Z[i]); } }
        Z[0] = MFMA16(TTf[0], dfrag(Z[0]), zero4);
        Z[1] = MFMA16(trfrag1(sAabT, 72, 4 * g4, 16, lane), dfrag(Z[0]), Z[1]);
        Z[1] = MFMA16(TTf[1], dfrag(Z[1]), zero4);
        Z[2] = MFMA16(trfrag(sAabT, 72, 4 * g4, 16 + 4 * g4, 32, lane), dfrag2(Z[0], Z[1]), Z[2]);
        Z[2] = MFMA16(TTf[2], dfrag(Z[2]), zero4);
        Z[3] = MFMA16(trfrag(sAabT, 72, 4 * g4, 16 + 4 * g4, 48, lane), dfrag2(Z[0], Z[1]), Z[3]);
        Z[3] = MFMA16(trfrag1(sAabT, 72, 32 + 4 * g4, 48, lane), dfrag(Z[2]), Z[3]);
        Z[3] = MFMA16(TTf[3], dfrag(Z[3]), zero4);
        {   const bf16x8 z01 = dfrag2(Z[0], Z[1]), z23 = dfrag2(Z[2], Z[3]);
#pragma unroll
            for (int i = 0; i < 4; ++i) {
                QY[i] = MFMA16(trfrag(sArbT, 72, 4 * g4, 16 + 4 * g4, 16 * i, lane), z01, zero4); QY[i] = MFMA16(trfrag(sArbT, 72, 32 + 4 * g4, 48 + 4 * g4, 16 * i, lane), z23, QY[i]);
                MN[i] = MFMA16(trfrag(sBh, 72, 4 * g4, 16 + 4 * g4, 16 * i, lane), z01, zero4); MN[i] = MFMA16(trfrag(sBh, 72, 32 + 4 * g4, 48 + 4 * g4, 16 * i, lane), z23, MN[i]); } }
        if (wave < 4) {
#pragma unroll
            for (int i = 0; i < 4; ++i) {
                const f32x4 radd = tr2f(trd4(sRt, 72, 16 * i + 4 * g4, 16 * wave, lane));
                f32x4 qv = QY[i] + radd, mv = MN[i];
                if (i == wave) { const float gm = sGam[16 * wave + cl];
#pragma unroll
                    for (int j = 0; j < 4; ++j) mv[j] += (4 * g4 + j == cl) ? gm : 0.f; }
                v2u wq; wq.x = pk2(qv[0], qv[1]); wq.y = pk2(qv[2], qv[3]); *(LAS v2u*)(sQhT + (16 * wave + cl) * 72 + 16 * i + 4 * g4) = wq;
                v2u wm; wm.x = pk2(mv[0], mv[1]); wm.y = pk2(mv[2], mv[3]); *(LAS v2u*)(sMmT + (16 * wave + cl) * 72 + 16 * i + 4 * g4) = wm; }
        } else { const int vt = wave - 4;
#pragma unroll
            for (int ks = 0; ks < 2; ++ks) { const bf16x8 vf = trfrag(sV, 72, 32 * ks + 8 * g4, 32 * ks + 8 * g4 + 4, 16 * vt, lane);
#pragma unroll
                for (int i = 0; i < 4; ++i) {
                    QY[i] = MFMA16(trfrag(sArkT, 72, 32 * ks + 8 * g4, 32 * ks + 8 * g4 + 4, 16 * i, lane), vf, QY[i]);
                    MN[i] = MFMA16(trfrag(sKh, 72, 32 * ks + 8 * g4, 32 * ks + 8 * g4 + 4, 16 * i, lane), vf, MN[i]); } } }
        __syncthreads();
        if (wave >= 4) { const int vt = wave - 4;
            const bf16x8 h01 = dfrag2(Hs[0], Hs[1]), h23 = dfrag2(Hs[2], Hs[3]);
#pragma unroll
            for (int i = 0; i < 4; ++i) {
                f32x4 y = MFMA16(trfrag(sQhT, 72, 4 * g4, 16 + 4 * g4, 16 * i, lane), h01, QY[i]); y = MFMA16(trfrag(sQhT, 72, 32 + 4 * g4, 48 + 4 * g4, 16 * i, lane), h23, y);
                f32x4 hn = MFMA16(trfrag(sMmT, 72, 4 * g4, 16 + 4 * g4, 16 * i, lane), h01, MN[i]); hn = MFMA16(trfrag(sMmT, 72, 32 + 4 * g4, 48 + 4 * g4, 16 * i, lane), h23, hn);
                MN[i] = hn;
#pragma unroll
                for (int j = 0; j < 4; ++j) sY[(16 * i + 4 * g4 + j) * 68 + 16 * vt + cl] = y[j]; }
#pragma unroll
            for (int i = 0; i < 4; ++i) Hs[i] = MN[i];
        }
        __syncthreads();
        {   float y[8], s1 = 0.f, s2 = 0.f, o[8];
            const f32x4 y0 = *(const LAS f32x4*)(sY + t * 68 + c8), y1 = *(const LAS f32x4*)(sY + t * 68 + c8 + 4);
            const f32x4 g0 = *(const LAS f32x4*)(sG + t * 68 + c8), g1 = *(const LAS f32x4*)(sG + t * 68 + c8 + 4);
            float vv[8]; unpack8(*(const LAS v4u*)(sV + t * 72 + c8), vv);
#pragma unroll
            for (int j = 0; j < 4; ++j) { y[j] = y0[j]; y[4 + j] = y1[j]; }
#pragma unroll
            for (int j = 0; j < 8; ++j) s1 += y[j];
            const float mean = add8(s1) * (1.0f / 64.0f);
#pragma unroll
            for (int j = 0; j < 8; ++j) { y[j] -= mean; s2 += y[j] * y[j]; }
            const float rstd = __builtin_amdgcn_rsqf(add8(s2) * (1.0f / 64.0f) + RWKV_GN_EPS), bon = sBonus[t];
#pragma unroll
            for (int j = 0; j < 8; ++j) o[j] = (y[j] * rstd * sC[384 + c8 + j] + sC[448 + c8 + j] + bon * vv[j]) * (j < 4 ? g0[j & 3] : g1[j & 3]);
            if (!dry) *(GAS v4u*)(F.P + (m0 + t) * LDP + C_RV + hc) = pack8(o);
        }
    }
    __syncthreads();
}

__device__ __forceinline__ void gla_item(Frame& F, int item, bool dry = false) {
    const int b = item >> 4, h = (item >> 2) & 3, vs = item & 3, tid = F.tid, wave = F.wave;
    LAS bf16* sQE = (LAS bf16*)F.lds; LAS bf16* sKE = sQE + 64 * 136; LAS bf16* sQD = sKE + 64 * 136; LAS bf16* sKD = sQD + 64 * 136; LAS bf16* sST = sKD + 64 * 136;
    LAS bf16* sV = sST + 64 * 136; LAS bf16* sScT = sV + 64 * 72;
    LAS float* sB = (LAS float*)(sScT + 64 * 72); LAS float* sO = (LAS float*)sQE;     LAS bf16* sGalB = (LAS bf16*)(sB + 64 * 132); LAS float* sTot = sB + 64 * 132 + 1024;
    LAS float* sEm = sTot + 512; LAS float* sEp = sEm + 128; LAS float* sEl = sEp + 128; LAS float* sGn = sEl + 128; LAS bf16* sOG = (LAS bf16*)(sGn + 64);
    const int t = tid >> 3, c16 = (tid & 7) * 16, c8 = (tid & 7) * 8;
    for (int i = tid; i < 64 * 136 / 2; i += 512) ((LAS unsigned*)sST)[i] = 0u;
    if (tid < 64) sGn[tid] = F.in[I_GLA_NORM][vs * 64 + tid];
    bf16x8 awf; float ab;
    {   const int lane0 = F.lane, colw = h * 128 + wave * 16 + (lane0 & 15), gq = lane0 >> 4; float a8[8];
#pragma unroll
        for (int j = 0; j < 8; ++j) a8[j] = (gq < 2) ? F.in[I_GLA_A_W2][(8 * gq + j) * 512 + colw] : 0.f;
        awf = __builtin_bit_cast(bf16x8, pack8(a8)); ab = F.in[I_GLA_A_B][colw]; }
    f32x4 accS[4];
#pragma unroll
    for (int i = 0; i < 4; ++i) accS[i] = (f32x4){0.f, 0.f, 0.f, 0.f};
    const float qscale = 0.08838834764831845f;
    v4u pq0, pq1, pk0, pk1, pvv, pga[4];
    const int lane0 = F.lane, cl0 = lane0 & 15, g40 = lane0 >> 4;
    {   const bf16* row = F.P + ((size_t)b * SEQ + t) * LDP;
        pq0 = *(const v4u*)(row + C_Q + h * 128 + c16); pq1 = *(const v4u*)(row + C_Q + h * 128 + c16 + 8); pk0 = *(const v4u*)(row + C_K + h * 128 + c16); pk1 = *(const v4u*)(row + C_K + h * 128 + c16 + 8);
        pvv = *(const v4u*)(row + C_GV + h * 256 + vs * 64 + c8);
#pragma unroll
        for (int ti = 0; ti < 4; ++ti) { pga[ti] = (v4u){0u, 0u, 0u, 0u}; if (g40 < 2) pga[ti] = *(const v4u*)(F.P + ((size_t)b * SEQ + 16 * ti + cl0) * LDP + C_GAL + 8 * g40); } }
    f32x4 bN[4];
#define GLA_G2() do { const f32x4 z4_ = {0.f, 0.f, 0.f, 0.f}; \
        _Pragma("unroll") for (int ti = 0; ti < 4; ++ti) { const f32x4 acc_ = MFMA16(__builtin_bit_cast(bf16x8, pga[ti]), awf, z4_); \
            _Pragma("unroll") for (int j = 0; j < 4; ++j) bN[ti][j] = -fsoftplus(-(ab + acc_[j])) * (1.0f / 16.0f); } \
        float base_ = 0.f; \
        _Pragma("unroll") for (int ti = 0; ti < 4; ++ti) { bN[ti][1] += bN[ti][0]; bN[ti][2] += bN[ti][1]; bN[ti][3] += bN[ti][2]; const float sg_ = bN[ti][3]; \
            const float s0_ = __shfl(sg_, cl0), s1_ = __shfl(sg_, cl0 + 16), s2_ = __shfl(sg_, cl0 + 32), s3_ = __shfl(sg_, cl0 + 48); \
            const float ex_ = base_ + ((g40 > 0) ? s0_ : 0.f) + ((g40 > 1) ? s1_ : 0.f) + ((g40 > 2) ? s2_ : 0.f); base_ += (s0_ + s1_) + (s2_ + s3_); \
            _Pragma("unroll") for (int j = 0; j < 4; ++j) bN[ti][j] += ex_; } } while (0)
    GLA_G2();
    __syncthreads();
    for (int c = 0; c < 32; ++c) {
        const size_t m0 = (size_t)b * SEQ + c * 64;
        int lane = F.lane; asm volatile("" : "+v"(lane));
        const int cl = lane & 15, g4 = lane >> 4;
        const v4u cq0 = pq0, cq1 = pq1, ck0 = pk0, ck1 = pk1;
        *(LAS v4u*)(sV + t * 72 + c8) = pvv;
        {   const int col = wave * 16 + cl;
#pragma unroll
            for (int ti = 0; ti < 4; ++ti)
#pragma unroll
                for (int j = 0; j < 4; ++j) sB[(ti * 16 + g4 * 4 + j) * 132 + col] = bN[ti][j];
            if (g4 == 3) { sEm[col] = fexp(-bN[1][3]); sEp[col] = fexp(bN[1][3]); sEl[col] = fexp(bN[3][3]); } }
        __syncthreads();
        {   float qe[16], ke[16], qd[16], kd[16];
            float q[16], k[16];
            {   float tmp[8];
                unpack8(cq0, tmp);
#pragma unroll
                for (int j = 0; j < 8; ++j) q[j] = tmp[j];
                unpack8(cq1, tmp);
#pragma unroll
                for (int j = 0; j < 8; ++j) q[8 + j] = tmp[j];
                unpack8(ck0, tmp);
#pragma unroll
                for (int j = 0; j < 8; ++j) k[j] = tmp[j];
                unpack8(ck1, tmp);
#pragma unroll
                for (int j = 0; j < 8; ++j) k[8 + j] = tmp[j]; }
            if (c < 31) { const bf16* row = F.P + (m0 + 64 + t) * LDP;
                pq0 = *(const v4u*)(row + C_Q + h * 128 + c16); pq1 = *(const v4u*)(row + C_Q + h * 128 + c16 + 8); pk0 = *(const v4u*)(row + C_K + h * 128 + c16); pk1 = *(const v4u*)(row + C_K + h * 128 + c16 + 8);
                pvv = *(const v4u*)(row + C_GV + h * 256 + vs * 64 + c8);
#pragma unroll
                for (int ti = 0; ti < 4; ++ti) if (g4 < 2) pga[ti] = *(const v4u*)(F.P + (m0 + 64 + 16 * ti + cl) * LDP + C_GAL + 8 * g4); }
#pragma unroll
            for (int j4 = 0; j4 < 4; ++j4) {
                const f32x4 bb = *(const LAS f32x4*)(sB + t * 132 + c16 + 4 * j4), em = *(const LAS f32x4*)(sEm + c16 + 4 * j4), ep = *(const LAS f32x4*)(sEp + c16 + 4 * j4), el = *(const LAS f32x4*)(sEl + c16 + 4 * j4);
#pragma unroll
                for (int jj = 0; jj < 4; ++jj) { const int j = 4 * j4 + jj; const float eb = fexp(bb[jj]), ieb = __builtin_amdgcn_rcpf(eb);
                    qd[j] = q[j] * qscale * eb; qe[j] = qd[j] * em[jj]; const float ki = k[j] * ieb; ke[j] = ki * ep[jj]; kd[j] = ki * el[jj]; } }
            float tmp[8];
#pragma unroll
            for (int hh = 0; hh < 2; ++hh) {
#pragma unroll
                for (int j = 0; j < 8; ++j) tmp[j] = qe[8 * hh + j];
                *(LAS v4u*)(sQE + t * 136 + c16 + 8 * hh) = pack8(tmp);
#pragma unroll
                for (int j = 0; j < 8; ++j) tmp[j] = ke[8 * hh + j];
                *(LAS v4u*)(sKE + t * 136 + c16 + 8 * hh) = pack8(tmp);
#pragma unroll
                for (int j = 0; j < 8; ++j) tmp[j] = qd[8 * hh + j];
                *(LAS v4u*)(sQD + t * 136 + c16 + 8 * hh) = pack8(tmp);
#pragma unroll
                for (int j = 0; j < 8; ++j) tmp[j] = kd[8 * hh + j];
                *(LAS v4u*)(sKD + t * 136 + c16 + 8 * hh) = pack8(tmp); }
        }
        __syncthreads();
#pragma unroll
        for (int e = 0; e < 2; ++e) { const int tile = 2 * wave + e, ti = tile >> 2, si = tile & 3;
            f32x4 acc = {0.f, 0.f, 0.f, 0.f};
            if (si <= ti) {
#pragma unroll
                for (int ks = 0; ks < 4; ++ks) acc = MFMA16(lfrag(sQE, 136, ti * 16, ks * 32, lane), lfrag(sKE, 136, si * 16, ks * 32, lane), acc); }
            const int sc = si * 16 + cl, tr0 = ti * 16 + g4 * 4;
#pragma unroll
            for (int j = 0; j < 4; ++j) acc[j] = (sc <= tr0 + j) ? acc[j] : 0.f;
            v2u w; w.x = pk2(acc[0], acc[1]); w.y = pk2(acc[2], acc[3]);
            *(LAS v2u*)(sScT + sc * 72 + tr0) = w; }
        __syncthreads();
#pragma unroll
        for (int e = 0; e < 2; ++e) { const int tile = 2 * wave + e, ti = tile >> 2, vi = tile & 3;
            f32x4 acc = {0.f, 0.f, 0.f, 0.f};
#pragma unroll
            for (int ks = 0; ks < 2; ++ks) acc = MFMA16(trfrag(sScT, 72, 32 * ks + 8 * g4, 32 * ks + 8 * g4 + 4, 16 * ti, lane), trfrag(sV, 72, 32 * ks + 8 * g4, 32 * ks + 8 * g4 + 4, 16 * vi, lane), acc);
#pragma unroll
            for (int ks = 0; ks < 4; ++ks) acc = MFMA16(lfrag(sQD, 136, ti * 16, ks * 32, lane), lfrag(sST, 136, vi * 16, ks * 32, lane), acc);
#pragma unroll
            for (int j = 0; j < 4; ++j) sO[(ti * 16 + g4 * 4 + j) * 68 + vi * 16 + cl] = acc[j]; }
        {   const f32x4 dec = *(const LAS f32x4*)(sEl + wave * 16 + g4 * 4);
#pragma unroll
            for (int vi = 0; vi < 4; ++vi) accS[vi] = accS[vi] * dec;
#pragma unroll
            for (int ks = 0; ks < 2; ++ks) { const bf16x8 kf = trfrag(sKD, 136, 32 * ks + 8 * g4, 32 * ks + 8 * g4 + 4, 16 * wave, lane);
#pragma unroll
                for (int vi = 0; vi < 4; ++vi) accS[vi] = MFMA16(kf, trfrag(sV, 72, 32 * ks + 8 * g4, 32 * ks + 8 * g4 + 4, 16 * vi, lane), accS[vi]); } }
        if (c < 31) GLA_G2();
        __syncthreads();
#pragma unroll
        for (int vi = 0; vi < 4; ++vi) { v2u w; w.x = pk2(accS[vi][0], accS[vi][1]); w.y = pk2(accS[vi][2], accS[vi][3]);
            *(LAS v2u*)(sST + (vi * 16 + cl) * 136 + wave * 16 + g4 * 4) = w; }
        {   float o[8], ss = 0.f;
            const f32x4 o0 = *(const LAS f32x4*)(sO + t * 68 + c8), o1 = *(const LAS f32x4*)(sO + t * 68 + c8 + 4);
#pragma unroll
            for (int j = 0; j < 4; ++j) { o[j] = o0[j]; o[4 + j] = o1[j]; }
#pragma unroll
            for (int j = 0; j < 8; ++j) ss += o[j] * o[j];
            ss = add8(ss);
            if (!dry) { if ((tid & 7) == 0) F.GS[(m0 + t) * 16 + h * 4 + vs] = ss;
                *(GAS v4u*)(F.P + (m0 + t) * LDP + C_GV + h * 256 + vs * 64 + c8) = pack8(o); }
        }
    }
}
#undef GLA_G2

__device__ __forceinline__ void gla_fixup(Frame& F) {
    const int gw = F.vcu * NWAVES + F.wave, NGW = F.G * NWAVES, lane = F.lane;
    const int hd = lane >> 4, v0 = (lane & 15) * 16;
    float gn[16];
#pragma unroll
    for (int j = 0; j < 16; ++j) gn[j] = F.in[I_GLA_NORM][v0 + j];
    for (int m = gw; m < M; m += 2 * NGW) {
        v4u ov[2][2], gvv[2][2]; float rs[2];
#pragma unroll
        for (int u = 0; u < 2; ++u) { const int mm = m + u * NGW; const bf16* prow = F.P + (size_t)mm * LDP;
            const f32x4 g4 = *(const f32x4*)(F.GS + (size_t)mm * 16 + hd * 4);
#pragma unroll
            for (int hh = 0; hh < 2; ++hh) { ov[u][hh] = *(const v4u*)(prow + C_GV + lane * 16 + 8 * hh); gvv[u][hh] = *(const v4u*)(prow + C_OG + lane * 16 + 8 * hh); }
            rs[u] = 1.0f / sqrtf(((g4[0] + g4[1]) + (g4[2] + g4[3])) * (1.0f / 256.0f) + GLA_NORM_EPS);
        }
#pragma unroll
        for (int u = 0; u < 2; ++u) { bf16* prow = F.P + (size_t)(m + u * NGW) * LDP;
#pragma unroll
            for (int hh = 0; hh < 2; ++hh) { float o[8], g[8]; unpack8(ov[u][hh], o); unpack8(gvv[u][hh], g);
#pragma unroll
                for (int j = 0; j < 8; ++j) o[j] = o[j] * rs[u] * gn[8 * hh + j] * (g[j] * fsig(g[j]));
                *(GAS v4u*)(prow + C_GV + lane * 16 + 8 * hh) = pack8(o); } }
    }
}
__device__ __forceinline__ void final_norm(Frame& F) {
    const int gw = F.vcu * NWAVES + F.wave, NGW = F.G * NWAVES, lane = F.lane;
    f32x4 gv[4];
#pragma unroll
    for (int j = 0; j < 4; ++j) gv[j] = ((const f32x4*)F.in[I_NORM_FINAL])[lane + 64 * j];
    for (int m = gw; m < M; m += 2 * NGW) {
        float rs[2]; f32x4 v[2][4];
#pragma unroll
        for (int u = 0; u < 2; ++u) { const int mm = m + u * NGW;
            const f32x4* sq = (const f32x4*)(F.SQ2 + (size_t)mm * 16); const f32x4 s0 = sq[0], s1 = sq[1], s2 = sq[2], s3 = sq[3];
            const GAS f32x4* xr = (const GAS f32x4*)(F.out + (size_t)mm * D) + lane;
#pragma unroll
            for (int j = 0; j < 4; ++j) v[u][j] = xr[64 * j];
            const float tot = ((s0[0] + s0[1]) + (s0[2] + s0[3])) + ((s1[0] + s1[1]) + (s1[2] + s1[3])) + ((s2[0] + s2[1]) + (s2[2] + s2[3])) + ((s3[0] + s3[1]) + (s3[2] + s3[3]));
            rs[u] = 1.0f / sqrtf(tot * (1.0f / 1024.0f) + NORM_EPS); }
#pragma unroll
        for (int u = 0; u < 2; ++u) { GAS f32x4* xr = (GAS f32x4*)(F.out + (size_t)(m + u * NGW) * D) + lane;
#pragma unroll
            for (int j = 0; j < 4; ++j) xr[64 * j] = v[u][j] * rs[u] * gv[j]; }
    }
}
__device__ __forceinline__ void lin_pass(Frame& F, int blk) {
    const int tid = F.tid, r = tid >> 2, q = tid & 3; const size_t m = (size_t)blk * 128 + r;
    const bf16* row = F.P + m * LDP + C_WL + q * 64; const bool hasprev = (m % SEQ) != 0; const float* mu = F.in[I_MU] + 3072 + q * 64;
#pragma unroll
    for (int p = 0; p < 8; ++p) { float cur[8], prv[8], z[8];
        unpack8(*(const v4u*)(row + 8 * p), cur);
        if (hasprev) unpack8(*(const v4u*)(row - LDP + 8 * p), prv); else {
#pragma unroll
            for (int j = 0; j < 8; ++j) prv[j] = 0.f; }
#pragma unroll
        for (int j = 0; j < 8; ++j) { const float zz = cur[j] + (prv[j] - cur[j]) * mu[8 * p + j];
            z[j] = (q == 0) ? (1.0f - 2.0f * __builtin_amdgcn_rcpf(1.0f + fexp(2.0f * zz))) : ((q == 1) ? zz : fsig(zz)); }
        *(GAS v4u*)(F.LIN + m * 256 + q * 64 + 8 * p) = pack8(z); }
}
constexpr int N_PHASES = 10;
struct Args { const float* in[24]; float* out; unsigned char* ws; int ph_lo, ph_hi; };
__global__ void __launch_bounds__(NWAVES * 64, 2) mk_fwd(Args args) {
    extern __shared__ __attribute__((aligned(16))) unsigned char lds[];
    Frame F;
    F.lds = (LAS unsigned char*)lds;
    F.MISC = (volatile LAS unsigned*)(F.lds + MISC_OFF);
    F.tid = threadIdx.x; F.lane = F.tid & 63; F.wave = __builtin_amdgcn_readfirstlane(F.tid >> 6);
    F.G = gridDim.x; { const int bx = blockIdx.x; F.vcu = (F.G % 8 == 0) ? (bx % 8) * (F.G / 8) + bx / 8 : bx; }
    unsigned char* ws = args.ws;
    F.ctl = (gu32*)(ws + WS_CTL);
#pragma unroll
    for (int i = 0; i < 24; ++i) F.in[i] = args.in[i];
    F.out = args.out;
    F.WIN = (bf16*)(ws + WS_WIN); F.WBR = (bf16*)(ws + WS_WBR); F.WOUT = (bf16*)(ws + WS_WOUT); F.WUP = (bf16*)(ws + WS_WUP); F.WDN = (bf16*)(ws + WS_WDN);
    F.LW = (bf16*)(ws + WS_LW); F.LA = (bf16*)(ws + WS_LA); F.LG = (bf16*)(ws + WS_LG); F.P = (bf16*)(ws + WS_P); F.XN = (bf16*)args.out;
    F.LIN = (bf16*)(ws + WS_LIN);
    F.GS = (float*)(ws + WS_GS); F.SQ1 = (float*)(ws + WS_SQ1); F.SQ2 = (float*)(ws + WS_SQ2);
    if (F.tid < 64) ((LAS unsigned*)(F.lds + MISC_OFF))[F.tid] = 0u;
    __syncthreads();
    const int lo = args.ph_lo, hi = args.ph_hi;
    XcdBarrier bar; bar.bar = (unsigned*)(F.ctl + CW_BAR); bar.x = 0; bar.st = nullptr;
    if (hi - lo > 1) bar = xcd_barrier_post((unsigned*)(F.ctl + CW_BAR), F.MISC + 8);
#define IN(k) (lo <= (k) && (k) < hi)
#define SEAM(k) do { if (IN(k) && IN((k) + 1)) xcd_barrier(bar); } while (0)
    LAS unsigned char* ring = F.lds;

    if (IN(0)) { p0_prologue(F); } SEAM(0);
    if (IN(1)) {
        pg8::Gemm g{F.XN, F.WIN, M, NA, D, D, D}; pg8::StaticOrder S; S.init(M, NA, F.G, (int)blockIdx.x);
        pg8::EpiStore<0> E{F.P, LDP, NA_VALID};
        pg8::gemm_phase<pg8::EpiStore<0>, pg8::StaticOrder, true, true>(ring, g, S, E);
    } SEAM(1);
#ifndef RWKV_IMPL
#define RWKV_IMPL rwkv_item
#endif
#ifndef GLA_IMPL
#define GLA_IMPL gla_item
#endif
    if (IN(2)) { if (F.vcu < BATCH * 16) { lin_pass(F, F.vcu); GLA_IMPL(F, F.vcu); } } SEAM(2);
    if (IN(3)) { __syncthreads(); if (F.vcu < BATCH * 16) RWKV_IMPL(F, F.vcu); }
    SEAM(3);
    if (IN(4)) {
        gla_fixup(F);
        pg8::Gemm g{F.XN, F.WIN + (size_t)NA * D, M, NG, D, D, D}; pg8::StaticOrder S; S.init(M, NG, F.G, (int)blockIdx.x);
        pg8::EpiStore<1> E{F.P + C_SG, LDP, NG};
        pg8::gemm_phase<pg8::EpiStore<1>, pg8::StaticOrder, true, true>(ring, g, S, E);
    } SEAM(4);
    if (IN(5)) {
        pg8::Gemm g{F.P + C_GV, F.WBR, M, D, 2 * D, LDP, 2 * D}; pg8::StaticOrder S; S.init(M, D, F.G, (int)blockIdx.x);
        pg8::EpiMerge2 E{F.P + C_SG, F.P + C_MIX, LDP};
        pg8::gemm_phase<pg8::EpiMerge2, pg8::StaticOrder, true, true>(ring, g, S, E);
    } SEAM(5);
    if (IN(6)) {
        pg8::Gemm g{F.P + C_MIX, F.WOUT, M, D, D, LDP, D}; pg8::StaticOrder S; S.init(M, D, F.G, (int)blockIdx.x);
        pg8::EpiRes<true> E{F.in[I_X], F.out, F.P + C_A2, LDP, F.SQ1};
        pg8::gemm_phase<pg8::EpiRes<true>, pg8::StaticOrder, true, true>(ring, g, S, E);
    } SEAM(6);
    if (IN(7)) {
        pg8::Gemm g{F.P + C_A2, F.WUP, M, FF, D, LDP, D}; pg8::StaticOrder S; S.init(M, FF, F.G, (int)blockIdx.x);
        pg8::EpiUp E{F.SQ1, F.P + C_H, LDP, NORM_EPS};
        pg8::gemm_phase<pg8::EpiUp, pg8::StaticOrder, true, true>(ring, g, S, E);
    } SEAM(7);
    if (IN(8)) {
        pg8::Gemm g{F.P + C_H, F.WDN, M, D, FF, LDP, FF}; pg8::StaticOrder S; S.init(M, D, F.G, (int)blockIdx.x);
        pg8::EpiResB E{F.P + C_A2, LDP, F.out, F.SQ2};
        pg8::gemm_phase<pg8::EpiResB, pg8::StaticOrder, true, true>(ring, g, S, E);
    } SEAM(8);
    if (IN(9)) { final_norm(F); }
#undef IN
#undef SEAM
}

extern "C" void kernel_launch(void* const* d_in, const int* in_sizes, int n_in, void* d_out, int out_size, void* d_ws, size_t ws_size, hipStream_t stream) {
    static int grid = 0;
    if (grid == 0) {
        if (n_in != 24 || in_sizes[0] != M * D || out_size != M * D || ws_size < WS_END) { fprintf(stderr, "kernel_launch: unexpected shapes (n_in %d, in0 %d, out %d, ws %zu, need %zu)\n", n_in, n_in > 0 ? in_sizes[0] : -1, out_size, ws_size, (size_t)WS_END); grid = -1; return; }
        int dev = 0, cus = 0, per_cu = 0;
        if (hipGetDevice(&dev) != hipSuccess || hipDeviceGetAttribute(&cus, hipDeviceAttributeMultiprocessorCount, dev) != hipSuccess) { grid = -1; return; }
        if (hipFuncSetAttribute((const void*)mk_fwd, hipFuncAttributeMaxDynamicSharedMemorySize, LDS_BYTES) != hipSuccess) { fprintf(stderr, "kernel_launch: hipFuncSetAttribute failed\n"); grid = -1; return; }
        if (hipOccupancyMaxActiveBlocksPerMultiprocessor(&per_cu, (const void*)mk_fwd, NWAVES * 64, LDS_BYTES) != hipSuccess || per_cu < 1) { fprintf(stderr, "kernel_launch: occupancy query says %d blocks per CU\n", per_cu); }
        (void)hipGetLastError();
        grid = cus;
        if (grid != 256) { fprintf(stderr, "kernel_launch: built for a 256-CU device (one mixer item per workgroup); found %d CUs; nothing launched\n", cus); grid = -1; return; }
    }
    if (grid < 0) return;
    (void)hipMemsetAsync((char*)d_ws + WS_CTL, 0, CTL_ZERO_BYTES, stream);
    Args a{};
    for (int i = 0; i < 24; ++i) a.in[i] = (const float*)d_in[i];
    a.out = (float*)d_out; a.ws = (unsigned char*)d_ws;
#if MK_SINGLE
    a.ph_lo = 0; a.ph_hi = N_PHASES;
    hipLaunchKernelGGL(mk_fwd, dim3(grid), dim3(NWAVES * 64), LDS_BYTES, stream, a);
#else
    for (int p = 0; p < N_PHASES; ++p) { a.ph_lo = p; a.ph_hi = p + 1; hipLaunchKernelGGL(mk_fwd, dim3(grid), dim3(NWAVES * 64), LDS_BYTES, stream, a); }
#endif
}
```

```cpp
#include <hip/hip_runtime.h>
#include <cstdio>
#include <cstdint>
#ifndef MK_SINGLE
#define MK_SINGLE 1
#endif
namespace pg8 {
#define PG8_LAS __attribute__((address_space(3)))
typedef unsigned short bf16_t;
typedef short bf16x8 __attribute__((ext_vector_type(8)));
typedef float f32x4 __attribute__((ext_vector_type(4)));
typedef unsigned u32x4 __attribute__((ext_vector_type(4)));
constexpr int BM = 256, BK = 64, HALF = 128, HTB = HALF * BK * 2  , STAGE_BYTES = 8 * HTB, NXCD = 8, WGM = 8;

__host__ __device__ __forceinline__ int lds_byte(int r, int c) { const int st = (r >> 4) * 2 + (c >> 5), rr = r & 15, cc = c & 31, ob = rr * 64 + cc * 2; return st * 1024 + (ob ^ (((ob >> 9) & 1) << 5)); }
__host__ __device__ __forceinline__ void stage_rc(int b, int& R, int& C) { const int st = b / 1024, sb = b % 1024, swz = sb ^ (((sb >> 9) & 1) << 5); R = (st >> 1) * 16 + swz / 64; C = (st & 1) * 32 + (swz % 64) / 2; }
__host__ __device__ __forceinline__ int perm32(int rho) { const int n = rho >> 4, i = rho & 15; return 8 * (i >> 2) + 4 * n + (i & 3); }

struct Unit { int pm, pn; };
struct Gemm { const bf16_t* A; const bf16_t* Bt; int M, N, K, lda, ldb; };

struct StaticOrder {
    int nM, nN, nwg, G, c;
    __host__ __device__ void init(int M, int N, int G_, int c_) { nM = M / BM; nN = N / BM; nwg = nM * nN; G = G_; c = c_; }
    __host__ __device__ bool next(int i, Unit& u) const {
        const long L = (long)i * G + c; if (L >= nwg) return false;
        int wgid = (int)L; { const int q = nwg / NXCD, r = nwg % NXCD, xcd = wgid % NXCD, off = wgid / NXCD; wgid = (xcd < r ? xcd * (q + 1) : r * (q + 1) + (xcd - r) * q) + off; }
        const int nig = WGM * nN, gid = wgid / nig, fm = gid * WGM, gsz = (nM - fm) < WGM ? (nM - fm) : WGM;
        u.pm = fm + ((wgid % nig) % gsz); u.pn = (wgid % nig) / gsz; return true;
    }
    __device__ __forceinline__ void a_ready(const Unit&) const {}
    __device__ __forceinline__ void done(const Unit&) const {}
};


typedef unsigned u32x2 __attribute__((ext_vector_type(2)));
typedef float f32x2_ __attribute__((ext_vector_type(2))); typedef __bf16 bf16x2_ __attribute__((ext_vector_type(2)));
__device__ __forceinline__ unsigned cvt_pk_bf16(float lo, float hi) { const f32x2_ v = {lo, hi}; return __builtin_bit_cast(unsigned, __builtin_convertvector(v, bf16x2_)); }
__device__ __forceinline__ float bf_lo(unsigned w) { return __uint_as_float(w << 16); }
__device__ __forceinline__ float bf_hi(unsigned w) { return __uint_as_float(w & 0xffff0000u); }
__device__ __forceinline__ float fsigmoid(float x) { return __builtin_amdgcn_rcpf(1.0f + __builtin_amdgcn_exp2f(-1.4426950408889634f * x)); }

template <int ACT> struct EpiStore {
    static constexpr bool PERM = true, AFTER_DRAIN = false; static constexpr int MIDK = 0, MIDSTEP = 0;
    bf16_t* O; int ldc; int ncol;
    __device__ __forceinline__ void operator()(const f32x4 (&acc)[2][2][4][2], const Unit& u, int wr, int wc, int fr, int fq) const {
        const int row0 = u.pm * BM + wr * 64 + fr, col0 = u.pn * BM + wc * 32 + 8 * fq;
#pragma unroll
        for (int ai = 0; ai < 2; ++ai)
#pragma unroll
            for (int m = 0; m < 4; ++m) { bf16_t* rowp = O + (size_t)(row0 + ai * HALF + m * 16) * ldc + col0;
#pragma unroll
                for (int bj = 0; bj < 2; ++bj) { if (col0 + bj * HALF >= ncol) continue;
                    f32x4 v0 = acc[ai][bj][m][0], v1 = acc[ai][bj][m][1];
                    if (ACT == 1) {
#pragma unroll
                        for (int j = 0; j < 4; ++j) { v0[j] = fsigmoid(v0[j]); v1[j] = fsigmoid(v1[j]); } }
                    u32x4 w; w.x = cvt_pk_bf16(v0[0], v0[1]); w.y = cvt_pk_bf16(v0[2], v0[3]); w.z = cvt_pk_bf16(v1[0], v1[1]); w.w = cvt_pk_bf16(v1[2], v1[3]);
                    *(u32x4*)(rowp + bj * HALF) = w; } }
    }
};
template <bool WITH_A2> struct EpiRes {
    static constexpr bool PERM = false, AFTER_DRAIN = false; static constexpr int MIDK = 0, MIDSTEP = 0;
    const float* X; float* X1; bf16_t* A2; int lda2; float* SQ;
    __device__ __forceinline__ void operator()(const f32x4 (&acc)[2][2][4][2], const Unit& u, int wr, int wc, int fr, int fq) const {
        const int row0 = u.pm * BM + wr * 64 + fr, col0 = u.pn * BM + wc * 32 + 4 * fq;
#pragma unroll
        for (int ai = 0; ai < 2; ++ai) {
            f32x4 xv[4][2][2];
#pragma unroll
            for (int m = 0; m < 4; ++m)
#pragma unroll
                for (int bj = 0; bj < 2; ++bj)
#pragma unroll
                    for (int n = 0; n < 2; ++n) xv[m][bj][n] = *(const f32x4*)(X + (size_t)(row0 + ai * HALF + m * 16) * 1024 + col0 + bj * HALF + n * 16);
#pragma unroll
            for (int m = 0; m < 4; ++m) { const int r = row0 + ai * HALF + m * 16; float ss = 0.f;
#pragma unroll
                for (int bj = 0; bj < 2; ++bj)
#pragma unroll
                    for (int n = 0; n < 2; ++n) { const int c = col0 + bj * HALF + n * 16;
                        const f32x4 o = xv[m][bj][n] + acc[ai][bj][m][n];
                        ss += (o[0] * o[0] + o[1] * o[1]) + (o[2] * o[2] + o[3] * o[3]);
                        if (WITH_A2) { u32x2 w; w.x = cvt_pk_bf16(o[0], o[1]); w.y = cvt_pk_bf16(o[2], o[3]); *(u32x2*)(A2 + (size_t)r * lda2 + c) = w; }
                        else *(f32x4*)(X1 + (size_t)r * 1024 + c) = o; }
                ss += __shfl_xor(ss, 16); ss += __shfl_xor(ss, 32);
                if (fq == 0) SQ[(size_t)r * 16 + u.pn * 4 + wc] = ss; } }
    }
};
struct EpiUp {
    static constexpr bool PERM = true, AFTER_DRAIN = false; static constexpr int MIDK = 0, MIDSTEP = 0;
    const float* SQ; bf16_t* H; int ldh; float eps;
    __device__ __forceinline__ void operator()(const f32x4 (&acc)[2][2][4][2], const Unit& u, int wr, int wc, int fr, int fq) const {
        const int row0 = u.pm * BM + wr * 64 + fr, col0 = u.pn * BM + wc * 32 + 8 * fq;
        f32x4 sq[2][4];
#pragma unroll
        for (int ai = 0; ai < 2; ++ai)
#pragma unroll
            for (int m = 0; m < 4; ++m) sq[ai][m] = *(const f32x4*)(SQ + (size_t)(row0 + ai * HALF + m * 16) * 16 + 4 * fq);
#pragma unroll
        for (int ai = 0; ai < 2; ++ai)
#pragma unroll
            for (int m = 0; m < 4; ++m) { const int r = row0 + ai * HALF + m * 16;
                float tot = (sq[ai][m][0] + sq[ai][m][1]) + (sq[ai][m][2] + sq[ai][m][3]); tot += __shfl_xor(tot, 16); tot += __shfl_xor(tot, 32);
                const float rs = __builtin_amdgcn_rsqf(tot * (1.0f / 1024.0f) + eps);
                bf16_t* rowp = H + (size_t)r * ldh + col0;
#pragma unroll
                for (int bj = 0; bj < 2; ++bj) { f32x4 v0 = acc[ai][bj][m][0] * rs, v1 = acc[ai][bj][m][1] * rs;
#pragma unroll
                    for (int j = 0; j < 4; ++j) { v0[j] = fmaxf(v0[j], 0.f); v0[j] *= v0[j]; v1[j] = fmaxf(v1[j], 0.f); v1[j] *= v1[j]; }
                    u32x4 w; w.x = cvt_pk_bf16(v0[0], v0[1]); w.y = cvt_pk_bf16(v0[2], v0[3]); w.z = cvt_pk_bf16(v1[0], v1[1]); w.w = cvt_pk_bf16(v1[2], v1[3]);
                    *(u32x4*)(rowp + bj * HALF) = w; } }
    }
};


struct EpiMerge2 {
    static constexpr bool PERM = true, AFTER_DRAIN = false; static constexpr int MIDK = 16, MIDSTEP = 16;
    const bf16_t* SG; bf16_t* O; int ld;
    __device__ __forceinline__ void mid(f32x4 (&acc)[2][2][4][2], const Unit& u, int t, int wr, int wc, int fr, int fq) const {
        int frv = fr, fqv = fq; asm volatile("" : "+v"(frv), "+v"(fqv));
        const int row0 = u.pm * BM + wr * 64 + frv, col0 = u.pn * BM + wc * 32 + 8 * fqv;
#pragma unroll
        for (int ai = 0; ai < 2; ++ai)
#pragma unroll
            for (int m = 0; m < 4; ++m) { const size_t ro = (size_t)(row0 + ai * HALF + m * 16) * ld + col0;
#pragma unroll
                for (int bj = 0; bj < 2; ++bj) { const u32x4 a = *(const u32x4*)(SG + ro + bj * HALF), b = *(const u32x4*)(SG + ro + bj * HALF + 1024);
                    f32x4& v0 = acc[ai][bj][m][0]; f32x4& v1 = acc[ai][bj][m][1];
                    v0[0] *= bf_lo(a.x) * __builtin_amdgcn_rcpf(bf_lo(b.x)); v0[1] *= bf_hi(a.x) * __builtin_amdgcn_rcpf(bf_hi(b.x));
                    v0[2] *= bf_lo(a.y) * __builtin_amdgcn_rcpf(bf_lo(b.y)); v0[3] *= bf_hi(a.y) * __builtin_amdgcn_rcpf(bf_hi(b.y));
                    v1[0] *= bf_lo(a.z) * __builtin_amdgcn_rcpf(bf_lo(b.z)); v1[1] *= bf_hi(a.z) * __builtin_amdgcn_rcpf(bf_hi(b.z));
                    v1[2] *= bf_lo(a.w) * __builtin_amdgcn_rcpf(bf_lo(b.w)); v1[3] *= bf_hi(a.w) * __builtin_amdgcn_rcpf(bf_hi(b.w)); } }
    }
    __device__ __forceinline__ void operator()(const f32x4 (&acc)[2][2][4][2], const Unit& u, int wr, int wc, int fr, int fq) const {
        const int row0 = u.pm * BM + wr * 64 + fr, col0 = u.pn * BM + wc * 32 + 8 * fq;
        u32x4 sb[2][4][2];
#pragma unroll
        for (int ai = 0; ai < 2; ++ai)
#pragma unroll
            for (int m = 0; m < 4; ++m)
#pragma unroll
                for (int bj = 0; bj < 2; ++bj) sb[ai][m][bj] = *(const u32x4*)(SG + (size_t)(row0 + ai * HALF + m * 16) * ld + col0 + bj * HALF + 1024);
#pragma unroll
        for (int ai = 0; ai < 2; ++ai)
#pragma unroll
            for (int m = 0; m < 4; ++m) { const size_t ro = (size_t)(row0 + ai * HALF + m * 16) * ld + col0;
#pragma unroll
                for (int bj = 0; bj < 2; ++bj) { const size_t off = ro + bj * HALF;
                    const u32x4 s = sb[ai][m][bj];
                    f32x4 v0 = acc[ai][bj][m][0], v1 = acc[ai][bj][m][1];
                    v0[0] *= bf_lo(s.x); v0[1] *= bf_hi(s.x); v0[2] *= bf_lo(s.y); v0[3] *= bf_hi(s.y);
                    v1[0] *= bf_lo(s.z); v1[1] *= bf_hi(s.z); v1[2] *= bf_lo(s.w); v1[3] *= bf_hi(s.w);
                    u32x4 w; w.x = cvt_pk_bf16(v0[0], v0[1]); w.y = cvt_pk_bf16(v0[2], v0[3]); w.z = cvt_pk_bf16(v1[0], v1[1]); w.w = cvt_pk_bf16(v1[2], v1[3]);
                    *(u32x4*)(O + off) = w; } }
    }
};

struct EpiResB {
    static constexpr bool PERM = false, AFTER_DRAIN = false; static constexpr int MIDK = 0, MIDSTEP = 0;
    const bf16_t* X1b; int lda1; float* X2; float* SQ;
    __device__ __forceinline__ void operator()(const f32x4 (&acc)[2][2][4][2], const Unit& u, int wr, int wc, int fr, int fq) const {
        const int row0 = u.pm * BM + wr * 64 + fr, col0 = u.pn * BM + wc * 32 + 4 * fq;
        u32x2 xb[2][4][2][2];
#pragma unroll
        for (int ai = 0; ai < 2; ++ai)
#pragma unroll
            for (int m = 0; m < 4; ++m)
#pragma unroll
                for (int bj = 0; bj < 2; ++bj)
#pragma unroll
                    for (int n = 0; n < 2; ++n) xb[ai][m][bj][n] = *(const u32x2*)(X1b + (size_t)(row0 + ai * HALF + m * 16) * lda1 + col0 + bj * HALF + n * 16);
#pragma unroll
        for (int ai = 0; ai < 2; ++ai)
#pragma unroll
            for (int m = 0; m < 4; ++m) { const int r = row0 + ai * HALF + m * 16; float ss = 0.f;
#pragma unroll
                for (int bj = 0; bj < 2; ++bj)
#pragma unroll
                    for (int n = 0; n < 2; ++n) { const int c = col0 + bj * HALF + n * 16; const u32x2 b2 = xb[ai][m][bj][n];
                        const f32x4 xv = {bf_lo(b2.x), bf_hi(b2.x), bf_lo(b2.y), bf_hi(b2.y)}; const f32x4 o = xv + acc[ai][bj][m][n];
                        *(f32x4*)(X2 + (size_t)r * 1024 + c) = o; ss += (o[0] * o[0] + o[1] * o[1]) + (o[2] * o[2] + o[3] * o[3]); }
                ss += __shfl_xor(ss, 16); ss += __shfl_xor(ss, 32);
                if (fq == 0) SQ[(size_t)r * 16 + u.pn * 4 + wc] = ss; }
    }
};
template <class Epi, class Sched, bool ALIGN_EPI = false, bool SP2 = false>
__device__ __forceinline__ void gemm_phase(PG8_LAS unsigned char* lds, const Gemm g, const Sched& S, const Epi& E) {
    const int tid = threadIdx.x, wid = __builtin_amdgcn_readfirstlane(tid >> 6), lane = tid & 63, wr = wid >> 2, wc = wid & 3, fr = lane & 15, fq = lane >> 4;
    const int K = g.K, nt = K / BK;
    unsigned voffA[2], voffB[2];
#pragma unroll
    for (int i = 0; i < 2; ++i) { int R, C; stage_rc(tid * 16 + i * 8192, R, C); const int Rb = Epi::PERM ? ((R & ~31) + perm32(R & 31)) : R;
        voffA[i] = (unsigned)(R * g.lda + C) * 2u; voffB[i] = (unsigned)(Rb * g.ldb + C) * 2u; }
    const size_t kstep = (size_t)(BK * 2);
    const size_t hstepA = (size_t)HALF * g.lda * 2, hstepB = (size_t)HALF * g.ldb * 2;
    const size_t tstepA = 2 * hstepA, tstepB = 2 * hstepB;
    const unsigned ldsw = (unsigned)wid * 1024u;
    const int aoff = lds_byte(wr * 64 + fr, fq * 8), boff = lds_byte(wc * 32 + fr, fq * 8);
#define PG8_SA(b, h) (((b) * 2 + (h)) * HTB)
#define PG8_SB(b, h) ((4 + (b) * 2 + (h)) * HTB)
#define PG8_STAGE(bufoff, gbase, voff) do { _Pragma("unroll") for (int _i = 0; _i < 2; ++_i) \
        __builtin_amdgcn_global_load_lds((const unsigned*)((const char*)(gbase) + (voff)[_i]), (PG8_LAS unsigned*)(lds + (bufoff) + ldsw + _i * 8192), 16, 0, 0); } while (0)
#define PG8_LDA(dst, b, h) do { _Pragma("unroll") for (int m = 0; m < 4; ++m) _Pragma("unroll") for (int k = 0; k < 2; ++k) dst[m][k] = *(const PG8_LAS bf16x8*)(lds + PG8_SA(b, h) + aoff + m * 2048 + k * 1024); } while (0)
#define PG8_LDB(dst, b, h) do { _Pragma("unroll") for (int n = 0; n < 2; ++n) _Pragma("unroll") for (int k = 0; k < 2; ++k) dst[n][k] = *(const PG8_LAS bf16x8*)(lds + PG8_SB(b, h) + boff + n * 2048 + k * 1024); } while (0)
#define PG8_MMA(ai, bj, At, Bt) do { __builtin_amdgcn_s_setprio(1); _Pragma("unroll") for (int m = 0; m < 4; ++m) _Pragma("unroll") for (int n = 0; n < 2; ++n) _Pragma("unroll") for (int k = 0; k < 2; ++k) \
        acc[ai][bj][m][n] = __builtin_amdgcn_mfma_f32_16x16x32_bf16(Bt[n][k], At[m][k], acc[ai][bj][m][n], 0, 0, 0); __builtin_amdgcn_s_setprio(0); } while (0)
#define PG8_WAIT_V(n) asm volatile("s_waitcnt vmcnt(" #n ")" ::: "memory")
#define PG8_WAIT_L(n) asm volatile("s_waitcnt lgkmcnt(" #n ")" ::: "memory")
#define PG8_BAR __builtin_amdgcn_s_barrier()
#define PG8_SCHED __builtin_amdgcn_sched_barrier(0)
    Unit cur, nxt; int ui = 0;
    if (!S.next(0, cur)) return;
    f32x4 acc[2][2][4][2];
#pragma unroll
    for (int a = 0; a < 2; ++a)
#pragma unroll
        for (int b = 0; b < 2; ++b)
#pragma unroll
            for (int m = 0; m < 4; ++m)
#pragma unroll
                for (int n = 0; n < 2; ++n) acc[a][b][m][n] = (f32x4){0.f, 0.f, 0.f, 0.f};
    bf16x8 At[4][2], B0[2][2], B1[2][2];
    const char* cA = (const char*)g.A + (size_t)cur.pm * tstepA; const char* cB = (const char*)g.Bt + (size_t)cur.pn * tstepB;
    S.a_ready(cur);
    if constexpr (SP2) {
        PG8_STAGE(PG8_SB(0, 0), cB, voffB); PG8_STAGE(PG8_SB(0, 1), cB + hstepB, voffB); PG8_STAGE(PG8_SA(0, 0), cA, voffA); PG8_STAGE(PG8_SA(0, 1), cA + hstepA, voffA);
        if (wr == 1) PG8_BAR;
        PG8_WAIT_V(2); PG8_BAR;
        PG8_STAGE(PG8_SB(1, 0), cB + kstep, voffB); PG8_STAGE(PG8_SA(1, 0), cA + kstep, voffA); PG8_STAGE(PG8_SB(1, 1), cB + hstepB + kstep, voffB);
        PG8_WAIT_V(6); PG8_BAR;
    } else {
        PG8_STAGE(PG8_SB(0, 0), cB, voffB); PG8_STAGE(PG8_SA(0, 0), cA, voffA); PG8_STAGE(PG8_SB(0, 1), cB + hstepB, voffB); PG8_STAGE(PG8_SA(0, 1), cA + hstepA, voffA);
        if (wr == 1) PG8_BAR;
        PG8_WAIT_V(4); PG8_BAR;
        PG8_STAGE(PG8_SB(1, 0), cB + kstep, voffB); PG8_STAGE(PG8_SA(1, 0), cA + kstep, voffA); PG8_STAGE(PG8_SB(1, 1), cB + hstepB + kstep, voffB);
        PG8_WAIT_V(6); PG8_BAR;
    }
    for (;;) {
        const bool has_next = S.next(ui + 1, nxt);
        const char* nA = has_next ? (const char*)g.A + (size_t)nxt.pm * tstepA : cA; const char* nB = has_next ? (const char*)g.Bt + (size_t)nxt.pn * tstepB : cB;
        for (int t = 0; t < nt; t += 2) {
            if constexpr (Epi::MIDK > 0) { if (t > 0 && t <= Epi::MIDK && (t % Epi::MIDSTEP) == 0) E.mid(acc, cur, t, wr, wc, fr, fq); }
            const bool last = (t == nt - 2);
            const char* a1 = cA + (size_t)(t + 1) * kstep;
            const char* a2 = last ? nA : cA + (size_t)(t + 2) * kstep; const char* b2 = last ? nB : cB + (size_t)(t + 2) * kstep;
            const char* a3 = a2 + kstep; const char* b3 = b2 + kstep;
            if (last && has_next) S.a_ready(nxt);
            if constexpr (SP2) {
            PG8_LDB(B0, 0, 0); PG8_LDB(B1, 0, 1); PG8_SCHED; PG8_LDA(At, 0, 0); PG8_STAGE(PG8_SA(1, 1), a1 + hstepA, voffA);
            PG8_WAIT_V(8); PG8_WAIT_L(0); PG8_BAR; PG8_MMA(0, 0, At, B0); PG8_MMA(0, 1, At, B1); PG8_BAR; PG8_SCHED;
            PG8_LDA(At, 0, 1); PG8_STAGE(PG8_SB(0, 0), b2, voffB); PG8_STAGE(PG8_SB(0, 1), b2 + hstepB, voffB); PG8_STAGE(PG8_SA(0, 0), a2, voffA);
            PG8_WAIT_V(8); PG8_WAIT_L(0); PG8_BAR; PG8_MMA(1, 0, At, B0); PG8_MMA(1, 1, At, B1); PG8_BAR; PG8_SCHED;
            PG8_LDB(B0, 1, 0); PG8_LDB(B1, 1, 1); PG8_SCHED; PG8_LDA(At, 1, 0); PG8_STAGE(PG8_SA(0, 1), a2 + hstepA, voffA);
            PG8_WAIT_V(8); PG8_WAIT_L(0); PG8_BAR; PG8_MMA(0, 0, At, B0); PG8_MMA(0, 1, At, B1); PG8_BAR; PG8_SCHED;
            PG8_LDA(At, 1, 1); PG8_STAGE(PG8_SB(1, 0), b3, voffB); PG8_STAGE(PG8_SB(1, 1), b3 + hstepB, voffB); PG8_STAGE(PG8_SA(1, 0), a3, voffA);
            PG8_WAIT_V(8); PG8_WAIT_L(0); PG8_BAR; PG8_MMA(1, 0, At, B0); PG8_MMA(1, 1, At, B1); PG8_BAR; PG8_SCHED;
            } else {
            PG8_LDB(B0, 0, 0); PG8_SCHED; PG8_LDA(At, 0, 0); PG8_STAGE(PG8_SA(1, 1), a1 + hstepA, voffA);
            PG8_WAIT_L(8); PG8_BAR; PG8_WAIT_L(0); PG8_MMA(0, 0, At, B0); PG8_BAR; PG8_SCHED;
            PG8_LDB(B1, 0, 1); PG8_STAGE(PG8_SB(0, 0), b2, voffB);
            PG8_BAR; PG8_WAIT_L(0); PG8_MMA(0, 1, At, B1); PG8_BAR;
            PG8_LDA(At, 0, 1); PG8_STAGE(PG8_SA(0, 0), a2, voffA);
            PG8_BAR; PG8_WAIT_L(0); PG8_MMA(1, 0, At, B0); PG8_BAR; PG8_SCHED;
            PG8_STAGE(PG8_SB(0, 1), b2 + hstepB, voffB);
            PG8_WAIT_V(6); PG8_BAR; PG8_MMA(1, 1, At, B1); PG8_BAR;
            PG8_LDB(B0, 1, 0); PG8_SCHED; PG8_LDA(At, 1, 0); PG8_STAGE(PG8_SA(0, 1), a2 + hstepA, voffA);
            PG8_WAIT_L(8); PG8_BAR; PG8_WAIT_L(0); PG8_MMA(0, 0, At, B0); PG8_BAR; PG8_SCHED;
            PG8_LDB(B1, 1, 1); PG8_STAGE(PG8_SB(1, 0), b3, voffB);
            PG8_BAR; PG8_WAIT_L(0); PG8_MMA(0, 1, At, B1); PG8_BAR;
            PG8_LDA(At, 1, 1); PG8_STAGE(PG8_SA(1, 0), a3, voffA);
            PG8_BAR; PG8_WAIT_L(0); PG8_MMA(1, 0, At, B0); PG8_BAR; PG8_SCHED;
            PG8_STAGE(PG8_SB(1, 1), b3 + hstepB, voffB);
            PG8_WAIT_V(6); PG8_BAR; PG8_MMA(1, 1, At, B1); PG8_BAR;
            }
        }
        if constexpr (ALIGN_EPI) { if (wr == 0) PG8_BAR; }
        if constexpr (!Epi::AFTER_DRAIN) { E(acc, cur, wr, wc, fr, fq); S.done(cur); }
        if (!has_next) break;
#pragma unroll
        for (int a = 0; a < 2; ++a)
#pragma unroll
            for (int b = 0; b < 2; ++b)
#pragma unroll
                for (int m = 0; m < 4; ++m)
#pragma unroll
                    for (int n = 0; n < 2; ++n) acc[a][b][m][n] = (f32x4){0.f, 0.f, 0.f, 0.f};
        cur = nxt; cA = nA; cB = nB; ++ui;
        if constexpr (ALIGN_EPI) { if (wr == 1) PG8_BAR; }
    }
    PG8_WAIT_V(0);
    if constexpr (!ALIGN_EPI) { if (wr == 0) PG8_BAR; }
    PG8_BAR;
    if constexpr (Epi::AFTER_DRAIN) { E.fused(acc, cur, wr, wc, fr, fq, lds, wid, lane); S.done(cur); }
#undef PG8_SA
#undef PG8_SB
#undef PG8_STAGE
#undef PG8_LDA
#undef PG8_LDB
#undef PG8_MMA
#undef PG8_WAIT_V
#undef PG8_WAIT_L
#undef PG8_BAR
#undef PG8_SCHED
}
}

constexpr int NWAVES = 8;
constexpr int BATCH = 16, SEQ = 2048, D = 1024, M = BATCH * SEQ, FF = 4096;
constexpr int LDP = 6656;
constexpr int C_Q = 0, C_K = 512, C_OG = 1024, C_GV = 2048, C_RV = 3072, C_RR = 4096, C_RK = 5120, C_WL = 6144, C_AL = 6208, C_GL = 6272, C_GAL = 6400, NA_VALID = 6416, NA = 6656, NG = 2048;
constexpr int C_MIX = 0, C_A2 = 1024, C_H = 2048, C_SG = 4096;
constexpr float NORM_EPS = 1e-6f, GLA_NORM_EPS = 1e-5f, RWKV_GN_EPS = 64e-5f;

constexpr size_t MiB = 1u << 20;
constexpr size_t WS_CTL = 0, CTL_ZERO_BYTES = 32768;
constexpr size_t WS_WIN = 2 * MiB;
constexpr size_t WS_WBR = 20 * MiB;
constexpr size_t WS_WOUT = 24 * MiB;
constexpr size_t WS_WUP = 26 * MiB;
constexpr size_t WS_WDN = 34 * MiB;
constexpr size_t WS_LW = 42 * MiB;
constexpr size_t WS_LA = WS_LW + 131072;
constexpr size_t WS_LG = WS_LA + 131072;
constexpr size_t WS_GS = 43 * MiB;
constexpr size_t WS_SQ1 = 45 * MiB;
constexpr size_t WS_SQ2 = 47 * MiB;
constexpr size_t WS_P = 64 * MiB;
constexpr size_t WS_LIN = WS_P + (size_t)M * LDP * 2;
constexpr size_t WS_END = WS_LIN + (size_t)M * 256 * 2;
static_assert(WS_END <= 512 * MiB, "d_ws map");
constexpr int CW_BAR = 4096;
constexpr int CW_PAN = 16384;

constexpr int LDS_BYTES = 160 * 1024;
constexpr int MISC_OFF = LDS_BYTES - 256;

#define GAS __attribute__((address_space(1)))
#define LAS __attribute__((address_space(3)))
typedef unsigned short bf16;
typedef unsigned v4u __attribute__((ext_vector_type(4)));
typedef unsigned v2u __attribute__((ext_vector_type(2)));
typedef float f32x4 __attribute__((ext_vector_type(4)));
typedef short bf16x8 __attribute__((ext_vector_type(8)));
typedef GAS unsigned gu32;
#define RLX_AGENT __ATOMIC_RELAXED, __HIP_MEMORY_SCOPE_AGENT
#define LDS_WAIT() asm volatile("s_waitcnt lgkmcnt(0)" ::: "memory")
#define VM_WAIT() asm volatile("s_waitcnt vmcnt(0)" ::: "memory")
__device__ __forceinline__ unsigned f2bf(float f) { unsigned u = __builtin_bit_cast(unsigned, f); return (u + 0x7fffu + ((u >> 16) & 1u)) >> 16; }
typedef float f32x2_t __attribute__((ext_vector_type(2))); typedef __bf16 bf16x2_t __attribute__((ext_vector_type(2)));
__device__ __forceinline__ unsigned pk2(float lo, float hi) { const f32x2_t v = {lo, hi}; return __builtin_bit_cast(unsigned, __builtin_convertvector(v, bf16x2_t)); }
__device__ __forceinline__ float bflo(unsigned w) { return __uint_as_float(w << 16); }
__device__ __forceinline__ float bfhi(unsigned w) { return __uint_as_float(w & 0xffff0000u); }
__device__ __forceinline__ void unpack8(const v4u w, float (&o)[8]) { o[0] = bflo(w.x); o[1] = bfhi(w.x); o[2] = bflo(w.y); o[3] = bfhi(w.y); o[4] = bflo(w.z); o[5] = bfhi(w.z); o[6] = bflo(w.w); o[7] = bfhi(w.w); }
__device__ __forceinline__ v4u pack8(const float (&v)[8]) { v4u w; w.x = pk2(v[0], v[1]); w.y = pk2(v[2], v[3]); w.z = pk2(v[4], v[5]); w.w = pk2(v[6], v[7]); return w; }
__device__ __forceinline__ float fexp(float x) { return __builtin_amdgcn_exp2f(1.4426950408889634f * x); }
__device__ __forceinline__ float fsig(float x) { return __builtin_amdgcn_rcpf(1.0f + fexp(-x)); }
__device__ __forceinline__ float fsoftplus(float x) { return fmaxf(x, 0.f) + __logf(1.0f + fexp(-fabsf(x))); }
__device__ __forceinline__ float add8(float x) {
    x += __int_as_float(__builtin_amdgcn_update_dpp(0, __float_as_int(x), 0xB1, 0xf, 0xf, false));
    x += __int_as_float(__builtin_amdgcn_update_dpp(0, __float_as_int(x), 0x4E, 0xf, 0xf, false));
    x += __int_as_float(__builtin_amdgcn_update_dpp(0, __float_as_int(x), 0x141, 0xf, 0xf, false));
    return x;
}
__device__ __forceinline__ bf16x8 lfrag(const LAS bf16* base, int ld, int r0, int k0, int lane) { return *(const LAS bf16x8*)(base + (r0 + (lane & 15)) * ld + k0 + 8 * (lane >> 4)); }
__device__ __forceinline__ bf16x8 gfrag(const bf16* base, int ld, int r0, int k0, int lane) { return *(const bf16x8*)(base + (size_t)(r0 + (lane & 15)) * ld + k0 + 8 * (lane >> 4)); }
#define MFMA16(a, b, c) __builtin_amdgcn_mfma_f32_16x16x32_bf16((a), (b), (c), 0, 0, 0)

#define XB_TMO      128
#define XB_XCNT(j)  (256  + 64 * (j))
#define XB_XSUB(j)  (1280 + 64 * (j))
#define XB_XGEN(j)  (2304 + 64 * (j))
#define XB_TOP      3328
#define XB_TOPGEN   3392
#define XCD_BAR_WORDS 3456
#define XB_SPIN_CAP (1u << 18)

__device__ __forceinline__ unsigned xb_ld(unsigned* p)              { return __hip_atomic_load(p, __ATOMIC_RELAXED, __HIP_MEMORY_SCOPE_AGENT); }
__device__ __forceinline__ unsigned xb_add(unsigned* p, unsigned v) { return __hip_atomic_fetch_add(p, v, __ATOMIC_RELAXED, __HIP_MEMORY_SCOPE_AGENT); }
__device__ __forceinline__ unsigned xb_xcc_id() { return (unsigned)__builtin_amdgcn_s_getreg((3 << 11) | 20) & 0xFu; }
#define XB_SPIN(cond, bar) do { unsigned _sp = 0; while (cond) { __builtin_amdgcn_s_sleep(1); \
    if ((++_sp & 255u) == 0u) { if (xb_ld(&(bar)[XB_TMO])) break; if (_sp > XB_SPIN_CAP) { atomicAdd(&(bar)[XB_TMO], 1u); break; } } } } while (0)

struct XcdBarrier {
    unsigned* bar; unsigned x;
    volatile LAS unsigned* st;
};

__device__ __forceinline__ XcdBarrier xcd_barrier_post(unsigned* bar, volatile LAS unsigned* st) {
    XcdBarrier b; b.bar = bar; b.x = xb_xcc_id(); b.st = st;
    if (threadIdx.x == 0) (void)xb_add(&bar[XB_XCNT(b.x)], 1u);
    return b;
}
__device__ __forceinline__ void xcd_barrier_complete(unsigned* bar, unsigned x, unsigned& nloc, unsigned& nx) {
    const unsigned G = gridDim.x * gridDim.y * gridDim.z;
    unsigned sum, cnt, mine, sp = 0u;
    for (;;) {
        sum = 0u; cnt = 0u; mine = 0u;
#pragma unroll
        for (unsigned j = 0; j < 16; ++j) { const unsigned c = xb_ld(&bar[XB_XCNT(j)]); sum += c; cnt += (c > 0u) ? 1u : 0u; mine = (j == x) ? c : mine; }
        if (sum == G) break;
        __builtin_amdgcn_s_sleep(1);
        if ((++sp & 255u) == 0u) { if (xb_ld(&bar[XB_TMO])) break; if (sp > XB_SPIN_CAP) { atomicAdd(&bar[XB_TMO], 1u); break; } }
    }
    nloc = mine > 0u ? mine : 1u; nx = cnt > 0u ? cnt : 1u;
}

__device__ __forceinline__ void xcd_barrier(const XcdBarrier& b) {
    asm volatile("s_waitcnt vmcnt(0)" ::: "memory");
    __syncthreads();
    if (threadIdx.x == 0) {
        unsigned* bar = b.bar;
        __builtin_amdgcn_s_waitcnt(0);
        unsigned nloc = b.st[0], nx = b.st[1];
        if (nloc == 0u) { xcd_barrier_complete(bar, b.x, nloc, nx); b.st[0] = nloc; b.st[1] = nx; }
        const unsigned old = xb_add(&bar[XB_XSUB(b.x)], 1u);
        const unsigned gen = old / nloc;
        if (old + 1u == (gen + 1u) * nloc) {
            __builtin_amdgcn_fence(__ATOMIC_RELEASE, "agent");
            asm volatile("s_waitcnt vmcnt(0)" ::: "memory");
            const unsigned og = xb_add(&bar[XB_TOP], 1u);
            const unsigned tg = og / nx;
            if (og + 1u == (tg + 1u) * nx) xb_add(&bar[XB_TOPGEN], 1u);
            else XB_SPIN(xb_ld(&bar[XB_TOPGEN]) == tg, bar);
            __builtin_amdgcn_fence(__ATOMIC_ACQUIRE, "agent");
            xb_add(&bar[XB_XGEN(b.x)], 1u);
            asm volatile("s_waitcnt vmcnt(0)" ::: "memory");
        } else {
            XB_SPIN(xb_ld(&bar[XB_XGEN(b.x)]) == gen, bar);
            __builtin_amdgcn_fence(__ATOMIC_ACQUIRE, "agent");
            asm volatile("s_waitcnt vmcnt(0)" ::: "memory");
        }
    }
    __syncthreads();
}

struct Frame {
    LAS unsigned char* lds;
    volatile LAS unsigned* MISC;
    gu32* ctl;
    int tid, lane, wave;
    int vcu, G;
    const float* in[24]; float* out;
    bf16 *WIN, *WBR, *WOUT, *WUP, *WDN, *LW, *LA, *LG, *P, *XN, *LIN;
    float *GS, *SQ1, *SQ2;
};
enum { I_X = 0, I_NORM_MIX, I_W_IN, I_GLA_A_W2, I_GLA_A_B, I_GLA_NORM, I_MU, I_W0, I_W_W2, I_A0, I_A_W2, I_G_W2, I_K_K, I_K_A, I_R_K, I_LN_W, I_LN_B, I_WB_GLA, I_WB_RWKV, I_W_OUT, I_NORM_MLP, I_W_UP, I_W_DOWN, I_NORM_FINAL };

__device__ __forceinline__ float wave_sum(float v) {
#pragma unroll
    for (int o = 1; o < 64; o <<= 1) v += __shfl_xor(v, o);
    return v;
}
__device__ __forceinline__ int win_src_col(int n) {
    if (n < 1024) return n;
    if (n < 2048) return n + 1024;
    if (n < 3072) return n - 1024;
    if (n < 4096) return n - 3072 + 5136;
    if (n < 6144) return n - 4096 + 3088;
    if (n < 6400) return n - 6144 + 6160;
    if (n < 6416) return n - 6400 + 3072;
    if (n < 6656) return -1;
    return n - 6656 + 6416;
}
__device__ __forceinline__ void tr_item(const float* W, int Nsrc, int sc4, int k0, const float* gk, bf16* WT, int ldk, int drow, int dk0, LAS float* scr, int lane) {
    const int r8 = lane >> 3, c4 = (lane & 7) * 4;
    f32x4 v[8];
#pragma unroll
    for (int i = 0; i < 8; ++i) { const int kk = 8 * i + r8;
        v[i] = (sc4 >= 0) ? *(const f32x4*)(W + (size_t)(k0 + kk) * Nsrc + sc4) : (f32x4){0.f, 0.f, 0.f, 0.f}; }
#pragma unroll
    for (int i = 0; i < 8; ++i) { const int kk = 8 * i + r8; f32x4 x = v[i]; if (gk) x = x * gk[k0 + kk];
        scr[kk * 33 + c4] = x[0]; scr[kk * 33 + c4 + 1] = x[1]; scr[kk * 33 + c4 + 2] = x[2]; scr[kk * 33 + c4 + 3] = x[3]; }
    LDS_WAIT(); asm volatile("" ::: "memory");
    const int c = lane & 7;
#pragma unroll
    for (int j = 0; j < 4; ++j) { const int n = (lane >> 3) + 8 * j; const LAS float* s = scr + (8 * c) * 33 + n;
        v4u o; o.x = pk2(s[0 * 33], s[1 * 33]); o.y = pk2(s[2 * 33], s[3 * 33]); o.z = pk2(s[4 * 33], s[5 * 33]); o.w = pk2(s[6 * 33], s[7 * 33]);
        *(GAS v4u*)(WT + (size_t)(drow + n) * ldk + dk0 + k0 + 8 * c) = o; }
    LDS_WAIT(); asm volatile("" ::: "memory");
}
__device__ __forceinline__ void p0_prologue(Frame& F) {
    LAS float* scr = (LAS float*)(F.lds + F.wave * 16384);
    const int gw = F.vcu * NWAVES + F.wave, NGW = F.G * NWAVES, lane = F.lane;
    constexpr int I_WIN = 16 * 272, I_B = 16 * 32, I_UP = 16 * 128, I_DN = 64 * 32, I_L64 = 32, I_L128 = 64;
    constexpr int NITEMS = I_WIN + 3 * I_B + I_UP + I_DN + 2 * I_L64 + I_L128;
    for (int it = gw; it < NITEMS; it += NGW) {
        int r = it;
        if (r < I_WIN) { const int kb = r / 272, nb = r % 272; tr_item(F.in[I_W_IN], 8464, win_src_col(32 * nb + ((lane & 7) * 4)), 64 * kb, nullptr, F.WIN, 1024, 32 * nb, 0, scr, lane); continue; } r -= I_WIN;
        if (r < I_B) { const int kb = r / 32, nb = r % 32; tr_item(F.in[I_WB_GLA], 1024, 32 * nb + ((lane & 7) * 4), 64 * kb, nullptr, F.WBR, 2048, 32 * nb, 0, scr, lane); continue; } r -= I_B;
        if (r < I_B) { const int kb = r / 32, nb = r % 32; tr_item(F.in[I_WB_RWKV], 1024, 32 * nb + ((lane & 7) * 4), 64 * kb, nullptr, F.WBR, 2048, 32 * nb, 1024, scr, lane); continue; } r -= I_B;
        if (r < I_B) { const int kb = r / 32, nb = r % 32; tr_item(F.in[I_W_OUT], 1024, 32 * nb + ((lane & 7) * 4), 64 * kb, nullptr, F.WOUT, 1024, 32 * nb, 0, scr, lane); continue; } r -= I_B;
        if (r < I_UP) { const int kb = r / 128, nb = r % 128; tr_item(F.in[I_W_UP], 4096, 32 * nb + ((lane & 7) * 4), 64 * kb, F.in[I_NORM_MLP], F.WUP, 1024, 32 * nb, 0, scr, lane); continue; } r -= I_UP;
        if (r < I_DN) { const int kb = r / 32, nb = r % 32; tr_item(F.in[I_W_DOWN], 1024, 32 * nb + ((lane & 7) * 4), 64 * kb, nullptr, F.WDN, 4096, 32 * nb, 0, scr, lane); continue; } r -= I_DN;
        if (r < I_L64) { tr_item(F.in[I_W_W2], 1024, 32 * r + ((lane & 7) * 4), 0, nullptr, F.LW, 64, 32 * r, 0, scr, lane); continue; } r -= I_L64;
        if (r < I_L64) { tr_item(F.in[I_A_W2], 1024, 32 * r + ((lane & 7) * 4), 0, nullptr, F.LA, 64, 32 * r, 0, scr, lane); continue; } r -= I_L64;
        { const int kb = r / 32, nb = r % 32; tr_item(F.in[I_G_W2], 1024, 32 * nb + ((lane & 7) * 4), 64 * kb, nullptr, F.LG, 128, 32 * nb, 0, scr, lane); }
    }
    const float* x = F.in[I_X]; const float* g = F.in[I_NORM_MIX];
    f32x4 gv[4];
#pragma unroll
    for (int j = 0; j < 4; ++j) gv[j] = ((const f32x4*)g)[lane + 64 * j];
    for (int m = gw; m < M; m += 4 * NGW) {
        f32x4 v[4][4]; float ss[4];
#pragma unroll
        for (int u = 0; u < 4; ++u) { const GAS f32x4* xr = (const GAS f32x4*)(x + (size_t)(m + u * NGW) * D) + lane;
#pragma unroll
            for (int j = 0; j < 4; ++j) v[u][j] = xr[64 * j]; }
#pragma unroll
        for (int u = 0; u < 4; ++u) { float s0 = 0.f;
#pragma unroll
            for (int j = 0; j < 4; ++j) s0 += (v[u][j].x * v[u][j].x + v[u][j].y * v[u][j].y) + (v[u][j].z * v[u][j].z + v[u][j].w * v[u][j].w);
            ss[u] = s0; }
#pragma unroll
        for (int o = 1; o < 64; o <<= 1) {
#pragma unroll
            for (int u = 0; u < 4; ++u) ss[u] += __shfl_xor(ss[u], o); }
#pragma unroll
        for (int u = 0; u < 4; ++u) { const float rs = __builtin_amdgcn_rsqf(ss[u] * (1.f / D) + NORM_EPS);
            GAS v2u* o8 = (GAS v2u*)(F.XN + (size_t)(m + u * NGW) * D) + lane;
#pragma unroll
            for (int j = 0; j < 4; ++j) { v2u w; w.x = pk2(v[u][j].x * rs * gv[j].x, v[u][j].y * rs * gv[j].y); w.y = pk2(v[u][j].z * rs * gv[j].z, v[u][j].w * rs * gv[j].w); o8[64 * j] = w; } }
    }
}

__device__ __forceinline__ bf16x8 dfrag(const f32x4 d) {
    const unsigned lo = pk2(d[0], d[1]), hi = pk2(d[2], d[3]); v4u w = {lo, hi, 0u, 0u}; return __builtin_bit_cast(bf16x8, w); }
__device__ __forceinline__ bf16x8 dfrag2(const f32x4 d0, const f32x4 d1) {
    v4u w = {pk2(d0[0], d0[1]), pk2(d0[2], d0[3]), pk2(d1[0], d1[1]), pk2(d1[2], d1[3])}; return __builtin_bit_cast(bf16x8, w); }
__device__ __forceinline__ bf16x8 pfrag(const LAS bf16* base, int ld, int row0, int col0, int col1, int lane) {
    const LAS bf16* p = base + (row0 + (lane & 15)) * ld + 4 * (lane >> 4);
    const v2u a = *(const LAS v2u*)(p + col0), b = *(const LAS v2u*)(p + col1); v4u w = {a.x, a.y, b.x, b.y}; return __builtin_bit_cast(bf16x8, w); }
__device__ __forceinline__ bf16x8 pfrag1(const LAS bf16* base, int ld, int row0, int col0, int lane) {
    const v2u a = *(const LAS v2u*)(base + (row0 + (lane & 15)) * ld + 4 * (lane >> 4) + col0); v4u w = {a.x, a.y, 0u, 0u}; return __builtin_bit_cast(bf16x8, w); }
__device__ __forceinline__ float ldbf(const LAS bf16* p) { return __uint_as_float(((unsigned)*p) << 16); }


typedef short s16x4 __attribute__((ext_vector_type(4)));
__device__ __forceinline__ s16x4 trd4(const LAS bf16* img, int ld, int row, int col0, int lane) {
    const int i = lane & 15; return __builtin_amdgcn_ds_read_tr16_b64_v4i16((LAS s16x4*)(img + (row + (i >> 2)) * ld + col0 + 4 * (i & 3))); }
__device__ __forceinline__ bf16x8 trfrag(const LAS bf16* img, int ld, int rowA, int rowB, int col0, int lane) {
    const s16x4 a = trd4(img, ld, rowA, col0, lane), b = trd4(img, ld, rowB, col0, lane); return (bf16x8){a[0], a[1], a[2], a[3], b[0], b[1], b[2], b[3]}; }
__device__ __forceinline__ bf16x8 trfrag1(const LAS bf16* img, int ld, int rowA, int col0, int lane) {
    const s16x4 a = trd4(img, ld, rowA, col0, lane); return (bf16x8){a[0], a[1], a[2], a[3], 0, 0, 0, 0}; }
__device__ __forceinline__ f32x4 tr2f(const s16x4 a) { return (f32x4){__uint_as_float(((unsigned)(unsigned short)a[0]) << 16), __uint_as_float(((unsigned)(unsigned short)a[1]) << 16), __uint_as_float(((unsigned)(unsigned short)a[2]) << 16), __uint_as_float(((unsigned)(unsigned short)a[3]) << 16)}; }

__device__ __forceinline__ void rwkv_item(Frame& F, int item, bool dry = false) {
    const int b = item >> 4, h = item & 15, tid = F.tid, wave = F.wave;
    LAS unsigned char* L = F.lds;
    LAS bf16* sAt = (LAS bf16*)L; LAS bf16* sRt = sAt + 4608; LAS bf16* sBt = sRt + 4608; LAS bf16* sKt = sBt + 4608;
    LAS bf16* sBh = sKt + 4608; LAS bf16* sKh = sBh + 4608; LAS bf16* sV = sKh + 4608;
    LAS bf16* sAabT = sV + 4608; LAS bf16* sAakT = sAabT + 4608; LAS bf16* sArbT = sAakT + 4608; LAS bf16* sArkT = sArbT + 4608;
    LAS bf16* sWL = sAabT; LAS bf16* sAL = sWL + 4608; LAS bf16* sGL = sAL + 4608;
    LAS bf16* sQhT = sBt; LAS bf16* sMmT = sKt;
    LAS float* sLW = (LAS float*)(sArkT + 4608); LAS float* sY = sLW;
    LAS float* sAa = sLW + 4352; LAS float* sG = sAa + 4352;
    LAS float* sTot = sG + 4352; LAS float* sBonus = sTot + 512; LAS float* sVlast = sBonus + 64; LAS float* sGam = sVlast + 128;
    LAS float* sC = sGam + 64;
    const int t = tid >> 3, kb = tid & 7, hc0 = h * 64 + kb * 8;
    {   const float* mu = F.in[I_MU];
        if (tid < 64) { const int ch = h * 64 + tid;
            sC[tid] = mu[ch]; sC[64 + tid] = mu[1024 + ch]; sC[128 + tid] = mu[2048 + ch]; sC[192 + tid] = F.in[I_K_K][ch]; sC[256 + tid] = F.in[I_K_A][ch];
            sC[320 + tid] = F.in[I_R_K][ch]; sC[384 + tid] = F.in[I_LN_W][ch]; sC[448 + tid] = F.in[I_LN_B][ch]; sC[512 + tid] = mu[3072 + tid]; sC[576 + tid] = mu[3136 + tid]; }
        else if (tid < 192) sC[640 + tid - 64] = mu[3200 + tid - 64];
    }
    const int wci = wave & 3;
    bf16x8 fL[4];
    bf16x8 fA[2];
    if (wave < 4) { fL[0] = gfrag(F.LW, 64, h * 64 + wci * 16, 0, F.lane); fL[1] = gfrag(F.LW, 64, h * 64 + wci * 16, 32, F.lane); fL[2] = fL[0]; fL[3] = fL[0]; fA[0] = fL[0]; fA[1] = fL[0]; }
    else {
#pragma unroll
        for (int ks = 0; ks < 4; ++ks) fL[ks] = gfrag(F.LG, 128, h * 64 + wci * 16, ks * 32, F.lane);
        fA[0] = gfrag(F.LA, 64, h * 64 + wci * 16, 0, F.lane); fA[1] = gfrag(F.LA, 64, h * 64 + wci * 16, 32, F.lane); }
    const float w0c = F.in[I_W0][h * 64 + wci * 16 + (F.lane & 15)], a0c = F.in[I_A0][h * 64 + wci * 16 + (F.lane & 15)];
    f32x4 Hs[4];
#pragma unroll
    for (int i = 0; i < 4; ++i) Hs[i] = (f32x4){0.f, 0.f, 0.f, 0.f};
    LAS bf16* sEx = (LAS bf16*)(sC + 768);
    if (tid < 48) ((LAS v4u*)(sEx + 7 * 192))[tid] = (v4u){0u, 0u, 0u, 0u};
    v4u pr, pk, pv, pwl, pal, pg0, pg1;
    {   const size_t mrow = (size_t)b * SEQ + t; const bf16* row = F.P + mrow * LDP; const bf16* lin = F.LIN + mrow * 256;
        pr = *(const v4u*)(row + C_RR + hc0); pk = *(const v4u*)(row + C_RK + hc0); pv = *(const v4u*)(row + C_RV + hc0);
        pwl = *(const v4u*)(lin + kb * 8); pal = *(const v4u*)(lin + 64 + kb * 8); pg0 = *(const v4u*)(lin + 128 + kb * 8); pg1 = *(const v4u*)(lin + 192 + kb * 8); }
    __syncthreads();
    for (int c = 0; c < 32; ++c) {
        const size_t m0 = (size_t)b * SEQ + c * 64;
        int hc = hc0, lane = F.lane; asm volatile("" : "+v"(hc), "+v"(lane));
        const int c8 = hc & 63, cl = lane & 15, g4 = lane >> 4;
        const v4u cr = pr, ck = pk, cv = pv;
        *(LAS v4u*)(sWL + t * 72 + c8) = pwl; *(LAS v4u*)(sAL + t * 72 + c8) = pal; *(LAS v4u*)(sGL + t * 136 + c8) = pg0; *(LAS v4u*)(sGL + t * 136 + 64 + c8) = pg1;
        {   LAS bf16* ex = sEx + ((wave < 7) ? wave : 7 + (c & 1)) * 192;
            if ((lane >> 3) == 7) { *(LAS v4u*)(ex + c8) = cr; *(LAS v4u*)(ex + 64 + c8) = ck; *(LAS v4u*)(ex + 128 + c8) = cv; } }
        __syncthreads();
        {   const int ch = wci * 16 + cl;
            if (wave < 4) {
                f32x4 lwv[4];
#pragma unroll
                for (int ti = 0; ti < 4; ++ti) { f32x4 accw = {0.f, 0.f, 0.f, 0.f};
#pragma unroll
                    for (int ks = 0; ks < 2; ++ks) accw = MFMA16(lfrag(sWL, 72, ti * 16, ks * 32, lane), fL[ks], accw);
#pragma unroll
                    for (int j = 0; j < 4; ++j) lwv[ti][j] = -0.6065306597126334f * fsig(w0c + accw[j]); }
                float base = 0.f;
#pragma unroll
                for (int ti = 0; ti < 4; ++ti) {
                    lwv[ti][1] += lwv[ti][0]; lwv[ti][2] += lwv[ti][1]; lwv[ti][3] += lwv[ti][2];
                    const float sg = lwv[ti][3];
                    const float s0 = __shfl(sg, cl), s1 = __shfl(sg, cl + 16), s2 = __shfl(sg, cl + 32), s3 = __shfl(sg, cl + 48);
                    const float ex = base + ((g4 > 0) ? s0 : 0.f) + ((g4 > 1) ? s1 : 0.f) + ((g4 > 2) ? s2 : 0.f);
                    base += (s0 + s1) + (s2 + s3);
#pragma unroll
                    for (int j = 0; j < 4; ++j) sLW[(ti * 16 + g4 * 4 + j) * 68 + ch] = lwv[ti][j] + ex; }
            } else {
#pragma unroll
                for (int ti = 0; ti < 4; ++ti) { f32x4 accg = {0.f, 0.f, 0.f, 0.f}, acca = accg;
#pragma unroll
                    for (int ks = 0; ks < 4; ++ks) accg = MFMA16(lfrag(sGL, 136, ti * 16, ks * 32, lane), fL[ks], accg);
#pragma unroll
                    for (int ks = 0; ks < 2; ++ks) acca = MFMA16(lfrag(sAL, 72, ti * 16, ks * 32, lane), fA[ks], acca);
#pragma unroll
                    for (int j = 0; j < 4; ++j) { sG[(ti * 16 + g4 * 4 + j) * 68 + ch] = accg[j]; sAa[(ti * 16 + g4 * 4 + j) * 68 + ch] = fsig(a0c + acca[j]); } } }
        }
            float rr[8], kr[8], vr[8];
            {   const bool first = (lane >> 3) == 0;
                const LAS bf16* ex = sEx + ((wave == 0) ? (7 + ((c + 1) & 1)) : (wave - 1)) * 192;
                v4u qr, qk, qv;
                qr.x = __shfl_up(cr.x, 8); qr.y = __shfl_up(cr.y, 8); qr.z = __shfl_up(cr.z, 8); qr.w = __shfl_up(cr.w, 8);
                qk.x = __shfl_up(ck.x, 8); qk.y = __shfl_up(ck.y, 8); qk.z = __shfl_up(ck.z, 8); qk.w = __shfl_up(ck.w, 8);
                qv.x = __shfl_up(cv.x, 8); qv.y = __shfl_up(cv.y, 8); qv.z = __shfl_up(cv.z, 8); qv.w = __shfl_up(cv.w, 8);
                if (first) { qr = *(const LAS v4u*)(ex + c8); qk = *(const LAS v4u*)(ex + 64 + c8); qv = *(const LAS v4u*)(ex + 128 + c8); }
                float cu[8], pv8[8];
                unpack8(cr, cu); unpack8(qr, pv8);
#pragma unroll
                for (int j = 0; j < 8; ++j) rr[j] = cu[j] + (pv8[j] - cu[j]) * sC[c8 + j];
                unpack8(ck, cu); unpack8(qk, pv8);
#pragma unroll
                for (int j = 0; j < 8; ++j) kr[j] = cu[j] + (pv8[j] - cu[j]) * sC[64 + c8 + j];
                unpack8(cv, cu); unpack8(qv, pv8);
#pragma unroll
                for (int j = 0; j < 8; ++j) vr[j] = cu[j] + (pv8[j] - cu[j]) * sC[128 + c8 + j];
            }
            if (c < 31) { const size_t mrow = m0 + 64 + t; const bf16* row = F.P + mrow * LDP; const bf16* lin = F.LIN + mrow * 256;
                pr = *(const v4u*)(row + C_RR + hc); pk = *(const v4u*)(row + C_RK + hc); pv = *(const v4u*)(row + C_RV + hc);
                pwl = *(const v4u*)(lin + c8); pal = *(const v4u*)(lin + 64 + c8); pg0 = *(const v4u*)(lin + 128 + c8); pg1 = *(const v4u*)(lin + 192 + c8); }
            float kkr[8], ss = 0.f, bon = 0.f;
#pragma unroll
            for (int j = 0; j < 8; ++j) { kkr[j] = kr[j] * sC[192 + c8 + j]; ss += kkr[j] * kkr[j]; }
            ss = add8(ss); const float inv = __builtin_amdgcn_rsqf(fmaxf(ss, 1e-24f));
        __syncthreads();
        {
            float tot[8];
            {   const f32x4 t0 = *(const LAS f32x4*)(sLW + 63 * 68 + c8), t1 = *(const LAS f32x4*)(sLW + 63 * 68 + c8 + 4);
#pragma unroll
                for (int j = 0; j < 4; ++j) { tot[j] = t0[j]; tot[4 + j] = t1[j]; } }
            float inc[8], pl[8], av[8];
            {   const f32x4 i0 = *(const LAS f32x4*)(sLW + t * 68 + c8), i1 = *(const LAS f32x4*)(sLW + t * 68 + c8 + 4);
                const f32x4 a0 = *(const LAS f32x4*)(sAa + t * 68 + c8), a1 = *(const LAS f32x4*)(sAa + t * 68 + c8 + 4);
                f32x4 p0 = {0.f, 0.f, 0.f, 0.f}, p1 = p0;
                if (t > 0) { p0 = *(const LAS f32x4*)(sLW + (t - 1) * 68 + c8); p1 = *(const LAS f32x4*)(sLW + (t - 1) * 68 + c8 + 4); }
#pragma unroll
                for (int j = 0; j < 4; ++j) { inc[j] = i0[j]; inc[4 + j] = i1[j]; pl[j] = p0[j]; pl[4 + j] = p1[j]; av[j] = a0[j]; av[4 + j] = a1[j]; } }
            float at[8], rt[8], bt[8], kt[8], bh[8], kh[8], etot[8];
#pragma unroll
            for (int j = 0; j < 8; ++j) etot[j] = fexp(tot[j]);
#pragma unroll
            for (int j = 0; j < 8; ++j) {
                const float gg = inc[j], gp = pl[j];
                const float a = av[j], kk = kkr[j] * inv, kp = kr[j] * (1.0f + (a - 1.0f) * sC[256 + c8 + j]);
                bon += rr[j] * kp * sC[320 + c8 + j];
                const float eg = fexp(gg), egp = fexp(gp), eng = fexp(-gg), ehl = etot[j] * eng, bv = kk * a;
                at[j] = -kk * egp; rt[j] = rr[j] * eg; bt[j] = bv * eng; kt[j] = kp * eng; bh[j] = bv * ehl; kh[j] = kp * ehl;
                if (t == 0) sGam[c8 + j] = etot[j]; }
            {   LAS bf16* tb = sAt;
                *(LAS v4u*)(tb + t * 72 + c8) = pack8(at); *(LAS v4u*)(tb + 4608 + t * 72 + c8) = pack8(rt);
                *(LAS v4u*)(tb + 2 * 4608 + t * 72 + c8) = pack8(bt); *(LAS v4u*)(tb + 3 * 4608 + t * 72 + c8) = pack8(kt); }
            *(LAS v4u*)(sBh + t * 72 + c8) = pack8(bh); *(LAS v4u*)(sKh + t * 72 + c8) = pack8(kh); *(LAS v4u*)(sV + t * 72 + c8) = pack8(vr);
            bon = add8(bon); if (kb == 0) sBonus[t] = bon;
        }
        __syncthreads();
#pragma unroll
        for (int e = 0; e < 8; ++e) { const int q = wave * 8 + e, o = q >> 4, ti = (q >> 2) & 3, si = q & 3;
            LAS bf16* dst = sAabT + o * 4608; const LAS bf16* as = (o < 2) ? sAt : sRt; const LAS bf16* bs = (o & 1) ? sKt : sBt;
            f32x4 acc = {0.f, 0.f, 0.f, 0.f};
            if (si <= ti) {
#pragma unroll
                for (int ks = 0; ks < 2; ++ks) acc = MFMA16(lfrag(as, 72, ti * 16, ks * 32, lane), lfrag(bs, 72, si * 16, ks * 32, lane), acc); }
            const int sc = si * 16 + cl, tr0 = ti * 16 + g4 * 4, dd = tr0 - sc - ((o < 2) ? 1 : 0);
#pragma unroll
            for (int j = 0; j < 4; ++j) acc[j] = (dd + j >= 0) ? acc[j] : 0.f;
            v2u w; w.x = pk2(acc[0], acc[1]); w.y = pk2(acc[2], acc[3]);
            *(LAS v2u*)(dst + sc * 72 + tr0) = w; }
        {   const int i = wave & 3; f32x4 Pm = {0.f, 0.f, 0.f, 0.f}, Qm = Pm, TT;
#pragma unroll
            for (int ks = 0; ks < 2; ++ks) { const bf16x8 af = lfrag(sAt, 72, i * 16, ks * 32, lane), bf = lfrag(sBt, 72, i * 16, ks * 32, lane);
                Pm = MFMA16(af, bf, Pm); Qm = MFMA16(bf, af, Qm); }
#pragma unroll
            for (int j = 0; j < 4; ++j) { Pm[j] = (cl < 4 * g4 + j) ? Pm[j] : 0.f; Qm[j] = (4 * g4 + j < cl) ? Qm[j] : 0.f;
                TT[j] = Qm[j] + ((4 * g4 + j == cl) ? 1.0f : 0.f); }
            const f32x4 z4 = {0.f, 0.f, 0.f, 0.f};
#pragma unroll
            for (int lvl = 0; lvl < 3; ++lvl) { const bf16x8 pf = dfrag(Pm), qf = dfrag(Qm);
                const f32x4 Pn = MFMA16(qf, pf, z4); if (lvl < 2) Qm = MFMA16(pf, qf, z4);
                Pm = Pn; TT = MFMA16(dfrag(Pm), dfrag(TT), TT); }
            if (wave < 4) { v2u w; w.x = pk2(TT[0], TT[1]); w.y = pk2(TT[2], TT[3]); *(LAS v2u*)((LAS unsigned char*)sTot + (i * 64 + lane) * 8) = w; }
        }
        __syncthreads();
        bf16x8 TTf[4];
#pragma unroll
        for (int i = 0; i < 4; ++i) { const v2u w = *(const LAS v2u*)((LAS unsigned char*)sTot + (i * 64 + lane) * 8); v4u x = {w.x, w.y, 0u, 0u}; TTf[i] = __builtin_bit_cast(bf16x8, x); }
        if (wave >= 4) { const int vt = wave - 4; const f32x4 zero4 = {0.f, 0.f, 0.f, 0.f};
            const bf16x8 h01 = dfrag2(Hs[0], Hs[1]), h23 = dfrag2(Hs[2], Hs[3]);
            f32x4 Z[4], Yt[4], Hn[4];
#pragma unroll
            for (int i = 0; i < 4; ++i) { Z[i] = zero4;
#pragma unroll
                for (int ks = 0; ks < 2; ++ks) Z[i] = MFMA16(trfrag(sAakT, 72, 32 * ks + 8 * g4, 32 * ks + 8 * g4 + 4, 16 * i, lane), trfrag(sV, 72, 32 * ks + 8 * g4, 32 * ks + 8 * g4 + 4, 16 * vt, lane), Z[i]);
                Z[i] = MFMA16(pfrag(sAt, 72, 16 * i, 0, 16, lane), h01, Z[i]); Z[i] = MFMA16(pfrag(sAt, 72, 16 * i, 32, 48, lane), h23, Z[i]); }
            Z[0] = MFMA16(TTf[0], dfrag(Z[0]), zero4);
            Z[1] = MFMA16(trfrag1(sAabT, 72, 4 * g4, 16, lane), dfrag(Z[0]), Z[1]);
            Z[1] = MFMA16(TTf[1], dfrag(Z[1]), zero4);
            Z[2] = MFMA16(trfrag(sAabT, 72, 4 * g4, 16 + 4 * g4, 32, lane), dfrag2(Z[0], Z[1]), Z[2]);
            Z[2] = MFMA16(TTf[2], dfrag(Z[2]), zero4);
            Z[3] = MFMA16(trfrag(sAabT, 72, 4 * g4, 16 + 4 * g4, 48, lane), dfrag2(Z[0], Z[1]), Z[3]);
            Z[3] = MFMA16(trfrag1(sAabT, 72, 32 + 4 * g4, 48, lane), dfrag(Z[2]), Z[3]);
            Z[3] = MFMA16(TTf[3], dfrag(Z[3]), zero4);
            const bf16x8 z01 = dfrag2(Z[0], Z[1]), z23 = dfrag2(Z[2], Z[3]);
#pragma unroll
            for (int i = 0; i < 4; ++i) {
                Yt[i] = MFMA16(trfrag(sArbT, 72, 4 * g4, 16 + 4 * g4, 16 * i, lane), z01, zero4); Yt[i] = MFMA16(trfrag(sArbT, 72, 32 + 4 * g4, 48 + 4 * g4, 16 * i, lane), z23, Yt[i]);
                Yt[i] = MFMA16(pfrag(sRt, 72, 16 * i, 0, 16, lane), h01, Yt[i]); Yt[i] = MFMA16(pfrag(sRt, 72, 16 * i, 32, 48, lane), h23, Yt[i]);
                const f32x4 gm = *(const LAS f32x4*)(sGam + 16 * i + 4 * g4);
                Hn[i] = Hs[i] * gm;
                Hn[i] = MFMA16(trfrag(sBh, 72, 4 * g4, 16 + 4 * g4, 16 * i, lane), z01, Hn[i]); Hn[i] = MFMA16(trfrag(sBh, 72, 32 + 4 * g4, 48 + 4 * g4, 16 * i, lane), z23, Hn[i]); }
#pragma unroll
            for (int ks = 0; ks < 2; ++ks) { const bf16x8 vf = trfrag(sV, 72, 32 * ks + 8 * g4, 32 * ks + 8 * g4 + 4, 16 * vt, lane);
#pragma unroll
                for (int i = 0; i < 4; ++i) {
                    Yt[i] = MFMA16(trfrag(sArkT, 72, 32 * ks + 8 * g4, 32 * ks + 8 * g4 + 4, 16 * i, lane), vf, Yt[i]);
                    Hn[i] = MFMA16(trfrag(sKh, 72, 32 * ks + 8 * g4, 32 * ks + 8 * g4 + 4, 16 * i, lane), vf, Hn[i]); } }
#pragma unroll
            for (int i = 0; i < 4; ++i) { Hs[i] = Hn[i];
#pragma unroll
                for (int j = 0; j < 4; ++j) sY[(16 * i + 4 * g4 + j) * 68 + 16 * vt + cl] = Yt[i][j]; }
        }
        __syncthreads();
        {   float y[8], s1 = 0.f, s2 = 0.f, o[8];
            const f32x4 y0 = *(const LAS f32x4*)(sY + t * 68 + c8), y1 = *(const LAS f32x4*)(sY + t * 68 + c8 + 4);
            const f32x4 g0 = *(const LAS f32x4*)(sG + t * 68 + c8), g1 = *(const LAS f32x4*)(sG + t * 68 + c8 + 4);
            float vv[8]; unpack8(*(const LAS v4u*)(sV + t * 72 + c8), vv);
#pragma unroll
            for (int j = 0; j < 4; ++j) { y[j] = y0[j]; y[4 + j] = y1[j]; }
#pragma unroll
            for (int j = 0; j < 8; ++j) s1 += y[j];
            const float mean = add8(s1) * (1.0f / 64.0f);
#pragma unroll
            for (int j = 0; j < 8; ++j) { y[j] -= mean; s2 += y[j] * y[j]; }
            const float rstd = __builtin_amdgcn_rsqf(add8(s2) * (1.0f / 64.0f) + RWKV_GN_EPS), bon = sBonus[t];
#pragma unroll
            for (int j = 0; j < 8; ++j) o[j] = (y[j] * rstd * sC[384 + c8 + j] + sC[448 + c8 + j] + bon * vv[j]) * (j < 4 ? g0[j & 3] : g1[j & 3]);
            if (!dry) *(GAS v4u*)(F.P + (m0 + t) * LDP + C_RV + hc) = pack8(o);
        }
    }
    __syncthreads();
}

__device__ __forceinline__ void gla_item(Frame& F, int item, bool dry = false) {
    const int b = item >> 4, h = (item >> 2) & 3, vs = item & 3, tid = F.tid, wave = F.wave;
    LAS bf16* sQE = (LAS bf16*)F.lds; LAS bf16* sKE = sQE + 64 * 136; LAS bf16* sQD = sKE + 64 * 136; LAS bf16* sKD = sQD + 64 * 136; LAS bf16* sST = sKD + 64 * 136;
    LAS bf16* sV = sST + 64 * 136; LAS bf16* sScT = sV + 64 * 72;
    LAS float* sB = (LAS float*)(sScT + 64 * 72); LAS float* sO = (LAS float*)sQE;     LAS bf16* sGalB = (LAS bf16*)(sB + 64 * 132); LAS float* sTot = sB + 64 * 132 + 1024;
    LAS float* sEm = sTot + 512; LAS float* sEp = sEm + 128; LAS float* sEl = sEp + 128; LAS float* sGn = sEl + 128; LAS bf16* sOG = (LAS bf16*)(sGn + 64);
    const int t = tid >> 3, c16 = (tid & 7) * 16, c8 = (tid & 7) * 8;
    for (int i = tid; i < 64 * 136 / 2; i += 512) ((LAS unsigned*)sST)[i] = 0u;
    if (tid < 64) sGn[tid] = F.in[I_GLA_NORM][vs * 64 + tid];
    bf16x8 awf; float ab;
    {   const int lane0 = F.lane, colw = h * 128 + wave * 16 + (lane0 & 15), gq = lane0 >> 4; float a8[8];
#pragma unroll
        for (int j = 0; j < 8; ++j) a8[j] = (gq < 2) ? F.in[I_GLA_A_W2][(8 * gq + j) * 512 + colw] : 0.f;
        awf = __builtin_bit_cast(bf16x8, pack8(a8)); ab = F.in[I_GLA_A_B][colw]; }
    f32x4 accS[4];
#pragma unroll
    for (int i = 0; i < 4; ++i) accS[i] = (f32x4){0.f, 0.f, 0.f, 0.f};
    const float qscale = 0.08838834764831845f;
    v4u pq0, pq1, pk0, pk1, pvv, pga[4];
    const int lane0 = F.lane, cl0 = lane0 & 15, g40 = lane0 >> 4;
    {   const bf16* row = F.P + ((size_t)b * SEQ + t) * LDP;
        pq0 = *(const v4u*)(row + C_Q + h * 128 + c16); pq1 = *(const v4u*)(row + C_Q + h * 128 + c16 + 8); pk0 = *(const v4u*)(row + C_K + h * 128 + c16); pk1 = *(const v4u*)(row + C_K + h * 128 + c16 + 8);
        pvv = *(const v4u*)(row + C_GV + h * 256 + vs * 64 + c8);
#pragma unroll
        for (int ti = 0; ti < 4; ++ti) { pga[ti] = (v4u){0u, 0u, 0u, 0u}; if (g40 < 2) pga[ti] = *(const v4u*)(F.P + ((size_t)b * SEQ + 16 * ti + cl0) * LDP + C_GAL + 8 * g40); } }
    f32x4 bN[4];
#define GLA_G2() do { const f32x4 z4_ = {0.f, 0.f, 0.f, 0.f}; \
        _Pragma("unroll") for (int ti = 0; ti < 4; ++ti) { const f32x4 acc_ = MFMA16(__builtin_bit_cast(bf16x8, pga[ti]), awf, z4_); \
            _Pragma("unroll") for (int j = 0; j < 4; ++j) bN[ti][j] = -fsoftplus(-(ab + acc_[j])) * (1.0f / 16.0f); } \
        float base_ = 0.f; \
        _Pragma("unroll") for (int ti = 0; ti < 4; ++ti) { bN[ti][1] += bN[ti][0]; bN[ti][2] += bN[ti][1]; bN[ti][3] += bN[ti][2]; const float sg_ = bN[ti][3]; \
            const float s0_ = __shfl(sg_, cl0), s1_ = __shfl(sg_, cl0 + 16), s2_ = __shfl(sg_, cl0 + 32), s3_ = __shfl(sg_, cl0 + 48); \
            const float ex_ = base_ + ((g40 > 0) ? s0_ : 0.f) + ((g40 > 1) ? s1_ : 0.f) + ((g40 > 2) ? s2_ : 0.f); base_ += (s0_ + s1_) + (s2_ + s3_); \
            _Pragma("unroll") for (int j = 0; j < 4; ++j) bN[ti][j] += ex_; } } while (0)
    GLA_G2();
    __syncthreads();
    for (int c = 0; c < 32; ++c) {
        const size_t m0 = (size_t)b * SEQ + c * 64;
        int lane = F.lane; asm volatile("" : "+v"(lane));
        const int cl = lane & 15, g4 = lane >> 4;
        const v4u cq0 = pq0, cq1 = pq1, ck0 = pk0, ck1 = pk1;
        *(LAS v4u*)(sV + t * 72 + c8) = pvv;
        {   const int col = wave * 16 + cl;
#pragma unroll
            for (int ti = 0; ti < 4; ++ti)
#pragma unroll
                for (int j = 0; j < 4; ++j) sB[(ti * 16 + g4 * 4 + j) * 132 + col] = bN[ti][j];
            if (g4 == 3) { sEm[col] = fexp(-bN[1][3]); sEp[col] = fexp(bN[1][3]); sEl[col] = fexp(bN[3][3]); } }
        __syncthreads();
        {   float qe[16], ke[16], qd[16], kd[16];
            float q[16], k[16];
            {   float tmp[8];
                unpack8(cq0, tmp);
#pragma unroll
                for (int j = 0; j < 8; ++j) q[j] = tmp[j];
                unpack8(cq1, tmp);
#pragma unroll
                for (int j = 0; j < 8; ++j) q[8 + j] = tmp[j];
                unpack8(ck0, tmp);
#pragma unroll
                for (int j = 0; j < 8; ++j) k[j] = tmp[j];
                unpack8(ck1, tmp);
#pragma unroll
                for (int j = 0; j < 8; ++j) k[8 + j] = tmp[j]; }
            if (c < 31) { const bf16* row = F.P + (m0 + 64 + t) * LDP;
                pq0 = *(const v4u*)(row + C_Q + h * 128 + c16); pq1 = *(const v4u*)(row + C_Q + h * 128 + c16 + 8); pk0 = *(const v4u*)(row + C_K + h * 128 + c16); pk1 = *(const v4u*)(row + C_K + h * 128 + c16 + 8);
                pvv = *(const v4u*)(row + C_GV + h * 256 + vs * 64 + c8);
#pragma unroll
                for (int ti = 0; ti < 4; ++ti) if (g4 < 2) pga[ti] = *(const v4u*)(F.P + (m0 + 64 + 16 * ti + cl) * LDP + C_GAL + 8 * g4); }
#pragma unroll
            for (int j4 = 0; j4 < 4; ++j4) {
                const f32x4 bb = *(const LAS f32x4*)(sB + t * 132 + c16 + 4 * j4), em = *(const LAS f32x4*)(sEm + c16 + 4 * j4), ep = *(const LAS f32x4*)(sEp + c16 + 4 * j4), el = *(const LAS f32x4*)(sEl + c16 + 4 * j4);
#pragma unroll
                for (int jj = 0; jj < 4; ++jj) { const int j = 4 * j4 + jj; const float eb = fexp(bb[jj]), ieb = __builtin_amdgcn_rcpf(eb);
                    qd[j] = q[j] * qscale * eb; qe[j] = qd[j] * em[jj]; const float ki = k[j] * ieb; ke[j] = ki * ep[jj]; kd[j] = ki * el[jj]; } }
            float tmp[8];
#pragma unroll
            for (int hh = 0; hh < 2; ++hh) {
#pragma unroll
                for (int j = 0; j < 8; ++j) tmp[j] = qe[8 * hh + j];
                *(LAS v4u*)(sQE + t * 136 + c16 + 8 * hh) = pack8(tmp);
#pragma unroll
                for (int j = 0; j < 8; ++j) tmp[j] = ke[8 * hh + j];
                *(LAS v4u*)(sKE + t * 136 + c16 + 8 * hh) = pack8(tmp);
#pragma unroll
                for (int j = 0; j < 8; ++j) tmp[j] = qd[8 * hh + j];
                *(LAS v4u*)(sQD + t * 136 + c16 + 8 * hh) = pack8(tmp);
#pragma unroll
                for (int j = 0; j < 8; ++j) tmp[j] = kd[8 * hh + j];
                *(LAS v4u*)(sKD + t * 136 + c16 + 8 * hh) = pack8(tmp); }
        }
        __syncthreads();
#pragma unroll
        for (int e = 0; e < 2; ++e) { const int tile = 2 * wave + e, ti = tile >> 2, si = tile & 3;
            f32x4 acc = {0.f, 0.f, 0.f, 0.f};
            if (si <= ti) {
#pragma unroll
                for (int ks = 0; ks < 4; ++ks) acc = MFMA16(lfrag(sQE, 136, ti * 16, ks * 32, lane), lfrag(sKE, 136, si * 16, ks * 32, lane), acc); }
            const int sc = si * 16 + cl, tr0 = ti * 16 + g4 * 4;
#pragma unroll
            for (int j = 0; j < 4; ++j) acc[j] = (sc <= tr0 + j) ? acc[j] : 0.f;
            v2u w; w.x = pk2(acc[0], acc[1]); w.y = pk2(acc[2], acc[3]);
            *(LAS v2u*)(sScT + sc * 72 + tr0) = w; }
        __syncthreads();
#pragma unroll
        for (int e = 0; e < 2; ++e) { const int tile = 2 * wave + e, ti = tile >> 2, vi = tile & 3;
            f32x4 acc = {0.f, 0.f, 0.f, 0.f};
#pragma unroll
            for (int ks = 0; ks < 2; ++ks) acc = MFMA16(trfrag(sScT, 72, 32 * ks + 8 * g4, 32 * ks + 8 * g4 + 4, 16 * ti, lane), trfrag(sV, 72, 32 * ks + 8 * g4, 32 * ks + 8 * g4 + 4, 16 * vi, lane), acc);
#pragma unroll
            for (int ks = 0; ks < 4; ++ks) acc = MFMA16(lfrag(sQD, 136, ti * 16, ks * 32, lane), lfrag(sST, 136, vi * 16, ks * 32, lane), acc);
#pragma unroll
            for (int j = 0; j < 4; ++j) sO[(ti * 16 + g4 * 4 + j) * 68 + vi * 16 + cl] = acc[j]; }
        {   const f32x4 dec = *(const LAS f32x4*)(sEl + wave * 16 + g4 * 4);
#pragma unroll
            for (int vi = 0; vi < 4; ++vi) accS[vi] = accS[vi] * dec;
#pragma unroll
            for (int ks = 0; ks < 2; ++ks) { const bf16x8 kf = trfrag(sKD, 136, 32 * ks + 8 * g4, 32 * ks + 8 * g4 + 4, 16 * wave, lane);
#pragma unroll
                for (int vi = 0; vi < 4; ++vi) accS[vi] = MFMA16(kf, trfrag(sV, 72, 32 * ks + 8 * g4, 32 * ks + 8 * g4 + 4, 16 * vi, lane), accS[vi]); } }
        if (c < 31) GLA_G2();
        __syncthreads();
#pragma unroll
        for (int vi = 0; vi < 4; ++vi) { v2u w; w.x = pk2(accS[vi][0], accS[vi][1]); w.y = pk2(accS[vi][2], accS[vi][3]);
            *(LAS v2u*)(sST + (vi * 16 + cl) * 136 + wave * 16 + g4 * 4) = w; }
        {   float o[8], ss = 0.f;
            const f32x4 o0 = *(const LAS f32x4*)(sO + t * 68 + c8), o1 = *(const LAS f32x4*)(sO + t * 68 + c8 + 4);
#pragma unroll
            for (int j = 0; j < 4; ++j) { o[j] = o0[j]; o[4 + j] = o1[j]; }
#pragma unroll
            for (int j = 0; j < 8; ++j) ss += o[j] * o[j];
            ss = add8(ss);
            if (!dry) { if ((tid & 7) == 0) F.GS[(m0 + t) * 16 + h * 4 + vs] = ss;
                *(GAS v4u*)(F.P + (m0 + t) * LDP + C_GV + h * 256 + vs * 64 + c8) = pack8(o); }
        }
    }
}
#undef GLA_G2

__device__ __forceinline__ void gla_fixup(Frame& F) {
    const int gw = F.vcu * NWAVES + F.wave, NGW = F.G * NWAVES, lane = F.lane;
    const int hd = lane >> 4, v0 = (lane & 15) * 16;
    float gn[16];
#pragma unroll
    for (int j = 0; j < 16; ++j) gn[j] = F.in[I_GLA_NORM][v0 + j];
    for (int m = gw; m < M; m += 2 * NGW) {
        v4u ov[2][2], gvv[2][2]; float rs[2];
#pragma unroll
        for (int u = 0; u < 2; ++u) { const int mm = m + u * NGW; const bf16* prow = F.P + (size_t)mm * LDP;
            const f32x4 g4 = *(const f32x4*)(F.GS + (size_t)mm * 16 + hd * 4);
#pragma unroll
            for (int hh = 0; hh < 2; ++hh) { ov[u][hh] = *(const v4u*)(prow + C_GV + lane * 16 + 8 * hh); gvv[u][hh] = *(const v4u*)(prow + C_OG + lane * 16 + 8 * hh); }
            rs[u] = 1.0f / sqrtf(((g4[0] + g4[1]) + (g4[2] + g4[3])) * (1.0f / 256.0f) + GLA_NORM_EPS);
        }
#pragma unroll
        for (int u = 0; u < 2; ++u) { bf16* prow = F.P + (size_t)(m + u * NGW) * LDP;
#pragma unroll
            for (int hh = 0; hh < 2; ++hh) { float o[8], g[8]; unpack8(ov[u][hh], o); unpack8(gvv[u][hh], g);
#pragma unroll
                for (int j = 0; j < 8; ++j) o[j] = o[j] * rs[u] * gn[8 * hh + j] * (g[j] * fsig(g[j]));
                *(GAS v4u*)(prow + C_GV + lane * 16 + 8 * hh) = pack8(o); } }
    }
}
__device__ __forceinline__ void final_norm(Frame& F) {
    const int gw = F.vcu * NWAVES + F.wave, NGW = F.G * NWAVES, lane = F.lane;
    f32x4 gv[4];
#pragma unroll
    for (int j = 0; j < 4; ++j) gv[j] = ((const f32x4*)F.in[I_NORM_FINAL])[lane + 64 * j];
    for (int m = gw; m < M; m += 2 * NGW) {
        float rs[2]; f32x4 v[2][4];
#pragma unroll
        for (int u = 0; u < 2; ++u) { const int mm = m + u * NGW;
            const f32x4* sq = (const f32x4*)(F.SQ2 + (size_t)mm * 16); const f32x4 s0 = sq[0], s1 = sq[1], s2 = sq[2], s3 = sq[3];
            const GAS f32x4* xr = (const GAS f32x4*)(F.out + (size_t)mm * D) + lane;
#pragma unroll
            for (int j = 0; j < 4; ++j) v[u][j] = xr[64 * j];
            const float tot = ((s0[0] + s0[1]) + (s0[2] + s0[3])) + ((s1[0] + s1[1]) + (s1[2] + s1[3])) + ((s2[0] + s2[1]) + (s2[2] + s2[3])) + ((s3[0] + s3[1]) + (s3[2] + s3[3]));
            rs[u] = 1.0f / sqrtf(tot * (1.0f / 1024.0f) + NORM_EPS); }
#pragma unroll
        for (int u = 0; u < 2; ++u) { GAS f32x4* xr = (GAS f32x4*)(F.out + (size_t)(m + u * NGW) * D) + lane;
#pragma unroll
            for (int j = 0; j < 4; ++j) xr[64 * j] = v[u][j] * rs[u] * gv[j]; }
    }
}
__device__ __forceinline__ void lin_pass(Frame& F, int blk) {
    const int tid = F.tid, r = tid >> 2, q = tid & 3; const size_t m = (size_t)blk * 128 + r;
    const bf16* row = F.P + m * LDP + C_WL + q * 64; const bool hasprev = (m % SEQ) != 0; const float* mu = F.in[I_MU] + 3072 + q * 64;
#pragma unroll
    for (int p = 0; p < 8; ++p) { float cur[8], prv[8], z[8];
        unpack8(*(const v4u*)(row + 8 * p), cur);
        if (hasprev) unpack8(*(const v4u*)(row - LDP + 8 * p), prv); else {
#pragma unroll
            for (int j = 0; j < 8; ++j) prv[j] = 0.f; }
#pragma unroll
        for (int j = 0; j < 8; ++j) { const float zz = cur[j] + (prv[j] - cur[j]) * mu[8 * p + j];
            z[j] = (q == 0) ? (1.0f - 2.0f * __builtin_amdgcn_rcpf(1.0f + fexp(2.0f * zz))) : ((q == 1) ? zz : fsig(zz)); }
        *(GAS v4u*)(F.LIN + m * 256 + q * 64 + 8 * p) = pack8(z); }
}
constexpr int N_PHASES = 10;
struct Args { const float* in[24]; float* out; unsigned char* ws; int ph_lo, ph_hi; };
__global__ void __launch_bounds__(NWAVES * 64, 2) mk_fwd(Args args) {
    extern __shared__ __attribute__((aligned(16))) unsigned char lds[];
    Frame F;
    F.lds = (LAS unsigned char*)lds;
    F.MISC = (volatile LAS unsigned*)(F.lds + MISC_OFF);
    F.tid = threadIdx.x; F.lane = F.tid & 63; F.wave = __builtin_amdgcn_readfirstlane(F.tid >> 6);
    F.G = gridDim.x; { const int bx = blockIdx.x; F.vcu = (F.G % 8 == 0) ? (bx % 8) * (F.G / 8) + bx / 8 : bx; }
    unsigned char* ws = args.ws;
    F.ctl = (gu32*)(ws + WS_CTL);
#pragma unroll
    for (int i = 0; i < 24; ++i) F.in[i] = args.in[i];
    F.out = args.out;
    F.WIN = (bf16*)(ws + WS_WIN); F.WBR = (bf16*)(ws + WS_WBR); F.WOUT = (bf16*)(ws + WS_WOUT); F.WUP = (bf16*)(ws + WS_WUP); F.WDN = (bf16*)(ws + WS_WDN);
    F.LW = (bf16*)(ws + WS_LW); F.LA = (bf16*)(ws + WS_LA); F.LG = (bf16*)(ws + WS_LG); F.P = (bf16*)(ws + WS_P); F.XN = (bf16*)args.out;
    F.LIN = (bf16*)(ws + WS_LIN);
    F.GS = (float*)(ws + WS_GS); F.SQ1 = (float*)(ws + WS_SQ1); F.SQ2 = (float*)(ws + WS_SQ2);
    if (F.tid < 64) ((LAS unsigned*)(F.lds + MISC_OFF))[F.tid] = 0u;
    __syncthreads();
    const int lo = args.ph_lo, hi = args.ph_hi;
    XcdBarrier bar; bar.bar = (unsigned*)(F.ctl + CW_BAR); bar.x = 0; bar.st = nullptr;
    if (hi - lo > 1) bar = xcd_barrier_post((unsigned*)(F.ctl + CW_BAR), F.MISC + 8);
#define IN(k) (lo <= (k) && (k) < hi)
#define SEAM(k) do { if (IN(k) && IN((k) + 1)) xcd_barrier(bar); } while (0)
    LAS unsigned char* ring = F.lds;

    if (IN(0)) { p0_prologue(F); } SEAM(0);
    if (IN(1)) {
        pg8::Gemm g{F.XN, F.WIN, M, NA, D, D, D}; pg8::StaticOrder S; S.init(M, NA, F.G, (int)blockIdx.x);
        pg8::EpiStore<0> E{F.P, LDP, NA_VALID};
        pg8::gemm_phase<pg8::EpiStore<0>, pg8::StaticOrder, true, true>(ring, g, S, E);
    } SEAM(1);
#ifndef RWKV_IMPL
#define RWKV_IMPL rwkv_item
#endif
#ifndef GLA_IMPL
#define GLA_IMPL gla_item
#endif
    if (IN(2)) { if (F.vcu < BATCH * 16) { lin_pass(F, F.vcu); GLA_IMPL(F, F.vcu); } } SEAM(2);
    if (IN(3)) { __syncthreads(); if (F.vcu < BATCH * 16) RWKV_IMPL(F, F.vcu); }
    SEAM(3);
    if (IN(4)) {
        gla_fixup(F);
        pg8::Gemm g{F.XN, F.WIN + (size_t)NA * D, M, NG, D, D, D}; pg8::StaticOrder S; S.init(M, NG, F.G, (int)blockIdx.x);
        pg8::EpiStore<1> E{F.P + C_SG, LDP, NG};
        pg8::gemm_phase<pg8::EpiStore<1>, pg8::StaticOrder, true, true>(ring, g, S, E);
    } SEAM(4);
    if (IN(5)) {
        pg8::Gemm g{F.P + C_GV, F.WBR, M, D, 2 * D, LDP, 2 * D}; pg8::StaticOrder S; S.init(M, D, F.G, (int)blockIdx.x);
        pg8::EpiMerge2 E{F.P + C_SG, F.P + C_MIX, LDP};
        pg8::gemm_phase<pg8::EpiMerge2, pg8::StaticOrder, true, true>(ring, g, S, E);
    } SEAM(5);
    if (IN(6)) {
        pg8::Gemm g{F.P + C_MIX, F.WOUT, M, D, D, LDP, D}; pg8::StaticOrder S; S.init(M, D, F.G, (int)blockIdx.x);
        pg8::EpiRes<true> E{F.in[I_X], F.out, F.P + C_A2, LDP, F.SQ1};
        pg8::gemm_phase<pg8::EpiRes<true>, pg8::StaticOrder, true, true>(ring, g, S, E);
    } SEAM(6);
    if (IN(7)) {
        pg8::Gemm g{F.P + C_A2, F.WUP, M, FF, D, LDP, D}; pg8::StaticOrder S; S.init(M, FF, F.G, (int)blockIdx.x);
        pg8::EpiUp E{F.SQ1, F.P + C_H, LDP, NORM_EPS};
        pg8::gemm_phase<pg8::EpiUp, pg8::StaticOrder, true, true>(ring, g, S, E);
    } SEAM(7);
    if (IN(8)) {
        pg8::Gemm g{F.P + C_H, F.WDN, M, D, FF, LDP, FF}; pg8::StaticOrder S; S.init(M, D, F.G, (int)blockIdx.x);
        pg8::EpiResB E{F.P + C_A2, LDP, F.out, F.SQ2};
        pg8::gemm_phase<pg8::EpiResB, pg8::StaticOrder, true, true>(ring, g, S, E);
    } SEAM(8);
    if (IN(9)) { final_norm(F); }
#undef IN
#undef SEAM
}

extern "C" void kernel_launch(void* const* d_in, const int* in_sizes, int n_in, void* d_out, int out_size, void* d_ws, size_t ws_size, hipStream_t stream) {
    static int grid = 0;
    if (grid == 0) {
        if (n_in != 24 || in_sizes[0] != M * D || out_size != M * D || ws_size < WS_END) { fprintf(stderr, "kernel_launch: unexpected shapes (n_in %d, in0 %d, out %d, ws %zu, need %zu)\n", n_in, n_in > 0 ? in_sizes[0] : -1, out_size, ws_size, (size_t)WS_END); grid = -1; return; }
        int dev = 0, cus = 0, per_cu = 0;
        if (hipGetDevice(&dev) != hipSuccess || hipDeviceGetAttribute(&cus, hipDeviceAttributeMultiprocessorCount, dev) != hipSuccess) { grid = -1; return; }
        if (hipFuncSetAttribute((const void*)mk_fwd, hipFuncAttributeMaxDynamicSharedMemorySize, LDS_BYTES) != hipSuccess) { fprintf(stderr, "kernel_launch: hipFuncSetAttribute failed\n"); grid = -1; return; }
        if (hipOccupancyMaxActiveBlocksPerMultiprocessor(&per_cu, (const void*)mk_fwd, NWAVES * 64, LDS_BYTES) != hipSuccess || per_cu < 1) { fprintf(stderr, "kernel_launch: occupancy query says %d blocks per CU\n", per_cu); }
        (void)hipGetLastError();
        grid = cus;
        if (grid != 256) { fprintf(stderr, "kernel_launch: built for a 256-CU device (one mixer item per workgroup); found %d CUs; nothing launched\n", cus); grid = -1; return; }
    }
    if (grid < 0) return;
    (void)hipMemsetAsync((char*)d_ws + WS_CTL, 0, CTL_ZERO_BYTES, stream);
    Args a{};
    for (int i = 0; i < 24; ++i) a.in[i] = (const float*)d_in[i];
    a.out = (float*)d_out; a.ws = (unsigned char*)d_ws;
#if MK_SINGLE
    a.ph_lo = 0; a.ph_hi = N_PHASES;
    hipLaunchKernelGGL(mk_fwd, dim3(grid), dim3(NWAVES * 64), LDS_BYTES, stream, a);
#else
    for (int p = 0; p < N_PHASES; ++p) { a.ph_lo = p; a.ph_hi = p + 1; hipLaunchKernelGGL(mk_fwd, dim3(grid), dim3(NWAVES * 64), LDS_BYTES, stream, a); }
#endif
}
```

```cpp
#define NGRP 4
#define GRP_MAP 0
#include <hip/hip_runtime.h>
#include <cstdio>
#include <cstdint>
#ifndef MK_SINGLE
#define MK_SINGLE 1
#endif
namespace pg8 {
#define PG8_LAS __attribute__((address_space(3)))
typedef unsigned short bf16_t;
typedef short bf16x8 __attribute__((ext_vector_type(8)));
typedef float f32x4 __attribute__((ext_vector_type(4)));
typedef unsigned u32x4 __attribute__((ext_vector_type(4)));
constexpr int BM = 256, BK = 64, HALF = 128, HTB = HALF * BK * 2  , STAGE_BYTES = 8 * HTB, NXCD = 8, WGM = 8;

__host__ __device__ __forceinline__ int lds_byte(int r, int c) { const int st = (r >> 4) * 2 + (c >> 5), rr = r & 15, cc = c & 31, ob = rr * 64 + cc * 2; return st * 1024 + (ob ^ (((ob >> 9) & 1) << 5)); }
__host__ __device__ __forceinline__ void stage_rc(int b, int& R, int& C) { const int st = b / 1024, sb = b % 1024, swz = sb ^ (((sb >> 9) & 1) << 5); R = (st >> 1) * 16 + swz / 64; C = (st & 1) * 32 + (swz % 64) / 2; }
__host__ __device__ __forceinline__ int perm32(int rho) { const int n = rho >> 4, i = rho & 15; return 8 * (i >> 2) + 4 * n + (i & 3); }

struct Unit { int pm, pn; };
struct Gemm { const bf16_t* A; const bf16_t* Bt; int M, N, K, lda, ldb; };

struct StaticOrder {
    int nM, nN, nwg, G, c, wgm, remap;
    __host__ __device__ void init(int M, int N, int G_, int c_, int wgm_ = WGM, int remap_ = 1) { nM = M / BM; nN = N / BM; nwg = nM * nN; G = G_; c = c_; wgm = wgm_; remap = remap_; }
    __host__ __device__ bool next(int i, Unit& u) const {
        const long L = (long)i * G + c; if (L >= nwg) return false;
        int wgid = (int)L; if (remap) { const int q = nwg / NXCD, r = nwg % NXCD, xcd = wgid % NXCD, off = wgid / NXCD; wgid = (xcd < r ? xcd * (q + 1) : r * (q + 1) + (xcd - r) * q) + off; }
        const int nig = wgm * nN, gid = wgid / nig, fm = gid * wgm, gsz = (nM - fm) < wgm ? (nM - fm) : wgm;
        u.pm = fm + ((wgid % nig) % gsz); u.pn = (wgid % nig) / gsz; return true;
    }
    __device__ __forceinline__ void a_ready(const Unit&) const {}
    __device__ __forceinline__ void done(const Unit&) const {}
};


typedef unsigned u32x2 __attribute__((ext_vector_type(2)));
typedef float f32x2_ __attribute__((ext_vector_type(2))); typedef __bf16 bf16x2_ __attribute__((ext_vector_type(2)));
__device__ __forceinline__ unsigned cvt_pk_bf16(float lo, float hi) { const f32x2_ v = {lo, hi}; return __builtin_bit_cast(unsigned, __builtin_convertvector(v, bf16x2_)); }
__device__ __forceinline__ float bf_lo(unsigned w) { return __uint_as_float(w << 16); }
__device__ __forceinline__ float bf_hi(unsigned w) { return __uint_as_float(w & 0xffff0000u); }
__device__ __forceinline__ float fsigmoid(float x) { return __builtin_amdgcn_rcpf(1.0f + __builtin_amdgcn_exp2f(-1.4426950408889634f * x)); }

template <int ACT> struct EpiStore {
    static constexpr bool PERM = true, AFTER_DRAIN = false; static constexpr int MIDK = 0, MIDSTEP = 0;
    bf16_t* O; int ldc; int ncol;
    __device__ __forceinline__ void operator()(const f32x4 (&acc)[2][2][4][2], const Unit& u, int wr, int wc, int fr, int fq) const {
        const int row0 = u.pm * BM + wr * 64 + fr, col0 = u.pn * BM + wc * 32 + 8 * fq;
#pragma unroll
        for (int ai = 0; ai < 2; ++ai)
#pragma unroll
            for (int m = 0; m < 4; ++m) { bf16_t* rowp = O + (size_t)(row0 + ai * HALF + m * 16) * ldc + col0;
#pragma unroll
                for (int bj = 0; bj < 2; ++bj) { if (col0 + bj * HALF >= ncol) continue;
                    f32x4 v0 = acc[ai][bj][m][0], v1 = acc[ai][bj][m][1];
                    if (ACT == 1) {
#pragma unroll
                        for (int j = 0; j < 4; ++j) { v0[j] = fsigmoid(v0[j]); v1[j] = fsigmoid(v1[j]); } }
                    u32x4 w; w.x = cvt_pk_bf16(v0[0], v0[1]); w.y = cvt_pk_bf16(v0[2], v0[3]); w.z = cvt_pk_bf16(v1[0], v1[1]); w.w = cvt_pk_bf16(v1[2], v1[3]);
                    *(u32x4*)(rowp + bj * HALF) = w; } }
    }
};
template <bool WITH_A2> struct EpiRes {
    static constexpr bool PERM = false, AFTER_DRAIN = false; static constexpr int MIDK = 0, MIDSTEP = 0;
    const float* X; float* X1; bf16_t* A2; int lda2; float* SQ;
    __device__ __forceinline__ void operator()(const f32x4 (&acc)[2][2][4][2], const Unit& u, int wr, int wc, int fr, int fq) const {
        const int row0 = u.pm * BM + wr * 64 + fr, col0 = u.pn * BM + wc * 32 + 4 * fq;
#pragma unroll
        for (int ai = 0; ai < 2; ++ai) {
            f32x4 xv[4][2][2];
#pragma unroll
            for (int m = 0; m < 4; ++m)
#pragma unroll
                for (int bj = 0; bj < 2; ++bj)
#pragma unroll
                    for (int n = 0; n < 2; ++n) xv[m][bj][n] = *(const f32x4*)(X + (size_t)(row0 + ai * HALF + m * 16) * 1024 + col0 + bj * HALF + n * 16);
#pragma unroll
            for (int m = 0; m < 4; ++m) { const int r = row0 + ai * HALF + m * 16; float ss = 0.f;
#pragma unroll
                for (int bj = 0; bj < 2; ++bj)
#pragma unroll
                    for (int n = 0; n < 2; ++n) { const int c = col0 + bj * HALF + n * 16;
                        const f32x4 o = xv[m][bj][n] + acc[ai][bj][m][n];
                        ss += (o[0] * o[0] + o[1] * o[1]) + (o[2] * o[2] + o[3] * o[3]);
                        if (WITH_A2) { u32x2 w; w.x = cvt_pk_bf16(o[0], o[1]); w.y = cvt_pk_bf16(o[2], o[3]); *(u32x2*)(A2 + (size_t)r * lda2 + c) = w; }
                        else *(f32x4*)(X1 + (size_t)r * 1024 + c) = o; }
                ss += __shfl_xor(ss, 16); ss += __shfl_xor(ss, 32);
                if (fq == 0) SQ[(size_t)r * 16 + u.pn * 4 + wc] = ss; } }
    }
};
struct EpiUp {
    static constexpr bool PERM = true, AFTER_DRAIN = false; static constexpr int MIDK = 0, MIDSTEP = 0;
    const float* SQ; bf16_t* H; int ldh; float eps;
    __device__ __forceinline__ void operator()(const f32x4 (&acc)[2][2][4][2], const Unit& u, int wr, int wc, int fr, int fq) const {
        const int row0 = u.pm * BM + wr * 64 + fr, col0 = u.pn * BM + wc * 32 + 8 * fq;
        f32x4 sq[2][4];
#pragma unroll
        for (int ai = 0; ai < 2; ++ai)
#pragma unroll
            for (int m = 0; m < 4; ++m) sq[ai][m] = *(const f32x4*)(SQ + (size_t)(row0 + ai * HALF + m * 16) * 16 + 4 * fq);
#pragma unroll
        for (int ai = 0; ai < 2; ++ai)
#pragma unroll
            for (int m = 0; m < 4; ++m) { const int r = row0 + ai * HALF + m * 16;
                float tot = (sq[ai][m][0] + sq[ai][m][1]) + (sq[ai][m][2] + sq[ai][m][3]); tot += __shfl_xor(tot, 16); tot += __shfl_xor(tot, 32);
                const float rs = __builtin_amdgcn_rsqf(tot * (1.0f / 1024.0f) + eps);
                bf16_t* rowp = H + (size_t)r * ldh + col0;
#pragma unroll
                for (int bj = 0; bj < 2; ++bj) { f32x4 v0 = acc[ai][bj][m][0] * rs, v1 = acc[ai][bj][m][1] * rs;
#pragma unroll
                    for (int j = 0; j < 4; ++j) { v0[j] = fmaxf(v0[j], 0.f); v0[j] *= v0[j]; v1[j] = fmaxf(v1[j], 0.f); v1[j] *= v1[j]; }
                    u32x4 w; w.x = cvt_pk_bf16(v0[0], v0[1]); w.y = cvt_pk_bf16(v0[2], v0[3]); w.z = cvt_pk_bf16(v1[0], v1[1]); w.w = cvt_pk_bf16(v1[2], v1[3]);
                    *(u32x4*)(rowp + bj * HALF) = w; } }
    }
};


struct EpiMerge2 {
    static constexpr bool PERM = true, AFTER_DRAIN = false; static constexpr int MIDK = 16, MIDSTEP = 16;
    const bf16_t* SG; bf16_t* O; int ld;
    __device__ __forceinline__ void mid(f32x4 (&acc)[2][2][4][2], const Unit& u, int t, int wr, int wc, int fr, int fq) const {
        int frv = fr, fqv = fq; asm volatile("" : "+v"(frv), "+v"(fqv));
        const int row0 = u.pm * BM + wr * 64 + frv, col0 = u.pn * BM + wc * 32 + 8 * fqv;
#pragma unroll
        for (int ai = 0; ai < 2; ++ai)
#pragma unroll
            for (int m = 0; m < 4; ++m) { const size_t ro = (size_t)(row0 + ai * HALF + m * 16) * ld + col0;
#pragma unroll
                for (int bj = 0; bj < 2; ++bj) { const u32x4 a = *(const u32x4*)(SG + ro + bj * HALF), b = *(const u32x4*)(SG + ro + bj * HALF + 1024);
                    f32x4& v0 = acc[ai][bj][m][0]; f32x4& v1 = acc[ai][bj][m][1];
                    v0[0] *= bf_lo(a.x) * __builtin_amdgcn_rcpf(bf_lo(b.x)); v0[1] *= bf_hi(a.x) * __builtin_amdgcn_rcpf(bf_hi(b.x));
                    v0[2] *= bf_lo(a.y) * __builtin_amdgcn_rcpf(bf_lo(b.y)); v0[3] *= bf_hi(a.y) * __builtin_amdgcn_rcpf(bf_hi(b.y));
                    v1[0] *= bf_lo(a.z) * __builtin_amdgcn_rcpf(bf_lo(b.z)); v1[1] *= bf_hi(a.z) * __builtin_amdgcn_rcpf(bf_hi(b.z));
                    v1[2] *= bf_lo(a.w) * __builtin_amdgcn_rcpf(bf_lo(b.w)); v1[3] *= bf_hi(a.w) * __builtin_amdgcn_rcpf(bf_hi(b.w)); } }
    }
    __device__ __forceinline__ void operator()(const f32x4 (&acc)[2][2][4][2], const Unit& u, int wr, int wc, int fr, int fq) const {
        const int row0 = u.pm * BM + wr * 64 + fr, col0 = u.pn * BM + wc * 32 + 8 * fq;
        u32x4 sb[2][4][2];
#pragma unroll
        for (int ai = 0; ai < 2; ++ai)
#pragma unroll
            for (int m = 0; m < 4; ++m)
#pragma unroll
                for (int bj = 0; bj < 2; ++bj) sb[ai][m][bj] = *(const u32x4*)(SG + (size_t)(row0 + ai * HALF + m * 16) * ld + col0 + bj * HALF + 1024);
#pragma unroll
        for (int ai = 0; ai < 2; ++ai)
#pragma unroll
            for (int m = 0; m < 4; ++m) { const size_t ro = (size_t)(row0 + ai * HALF + m * 16) * ld + col0;
#pragma unroll
                for (int bj = 0; bj < 2; ++bj) { const size_t off = ro + bj * HALF;
                    const u32x4 s = sb[ai][m][bj];
                    f32x4 v0 = acc[ai][bj][m][0], v1 = acc[ai][bj][m][1];
                    v0[0] *= bf_lo(s.x); v0[1] *= bf_hi(s.x); v0[2] *= bf_lo(s.y); v0[3] *= bf_hi(s.y);
                    v1[0] *= bf_lo(s.z); v1[1] *= bf_hi(s.z); v1[2] *= bf_lo(s.w); v1[3] *= bf_hi(s.w);
                    u32x4 w; w.x = cvt_pk_bf16(v0[0], v0[1]); w.y = cvt_pk_bf16(v0[2], v0[3]); w.z = cvt_pk_bf16(v1[0], v1[1]); w.w = cvt_pk_bf16(v1[2], v1[3]);
                    *(u32x4*)(O + off) = w; } }
    }
};

struct EpiResB {
    static constexpr bool PERM = false, AFTER_DRAIN = false; static constexpr int MIDK = 0, MIDSTEP = 0;
    const bf16_t* X1b; int lda1; float* X2; float* SQ;
    __device__ __forceinline__ void operator()(const f32x4 (&acc)[2][2][4][2], const Unit& u, int wr, int wc, int fr, int fq) const {
        const int row0 = u.pm * BM + wr * 64 + fr, col0 = u.pn * BM + wc * 32 + 4 * fq;
        u32x2 xb[2][4][2][2];
#pragma unroll
        for (int ai = 0; ai < 2; ++ai)
#pragma unroll
            for (int m = 0; m < 4; ++m)
#pragma unroll
                for (int bj = 0; bj < 2; ++bj)
#pragma unroll
                    for (int n = 0; n < 2; ++n) xb[ai][m][bj][n] = *(const u32x2*)(X1b + (size_t)(row0 + ai * HALF + m * 16) * lda1 + col0 + bj * HALF + n * 16);
#pragma unroll
        for (int ai = 0; ai < 2; ++ai)
#pragma unroll
            for (int m = 0; m < 4; ++m) { const int r = row0 + ai * HALF + m * 16; float ss = 0.f;
#pragma unroll
                for (int bj = 0; bj < 2; ++bj)
#pragma unroll
                    for (int n = 0; n < 2; ++n) { const int c = col0 + bj * HALF + n * 16; const u32x2 b2 = xb[ai][m][bj][n];
                        const f32x4 xv = {bf_lo(b2.x), bf_hi(b2.x), bf_lo(b2.y), bf_hi(b2.y)}; const f32x4 o = xv + acc[ai][bj][m][n];
                        *(f32x4*)(X2 + (size_t)r * 1024 + c) = o; ss += (o[0] * o[0] + o[1] * o[1]) + (o[2] * o[2] + o[3] * o[3]); }
                ss += __shfl_xor(ss, 16); ss += __shfl_xor(ss, 32);
                if (fq == 0) SQ[(size_t)r * 16 + u.pn * 4 + wc] = ss; }
    }
};
template <class Epi, class Sched, bool ALIGN_EPI = false, bool SP2 = false>
__device__ __forceinline__ void gemm_phase(PG8_LAS unsigned char* lds, const Gemm g, const Sched& S, const Epi& E) {
    const int tid = threadIdx.x, wid = __builtin_amdgcn_readfirstlane(tid >> 6), lane = tid & 63, wr = wid >> 2, wc = wid & 3, fr = lane & 15, fq = lane >> 4;
    const int K = g.K, nt = K / BK;
    unsigned voffA[2], voffB[2];
#pragma unroll
    for (int i = 0; i < 2; ++i) { int R, C; stage_rc(tid * 16 + i * 8192, R, C); const int Rb = Epi::PERM ? ((R & ~31) + perm32(R & 31)) : R;
        voffA[i] = (unsigned)(R * g.lda + C) * 2u; voffB[i] = (unsigned)(Rb * g.ldb + C) * 2u; }
    const size_t kstep = (size_t)(BK * 2);
    const size_t hstepA = (size_t)HALF * g.lda * 2, hstepB = (size_t)HALF * g.ldb * 2;
    const size_t tstepA = 2 * hstepA, tstepB = 2 * hstepB;
    const unsigned ldsw = (unsigned)wid * 1024u;
    const int aoff = lds_byte(wr * 64 + fr, fq * 8), boff = lds_byte(wc * 32 + fr, fq * 8);
#define PG8_SA(b, h) (((b) * 2 + (h)) * HTB)
#define PG8_SB(b, h) ((4 + (b) * 2 + (h)) * HTB)
#define PG8_STAGE(bufoff, gbase, voff) do { _Pragma("unroll") for (int _i = 0; _i < 2; ++_i) \
        __builtin_amdgcn_global_load_lds((const unsigned*)((const char*)(gbase) + (voff)[_i]), (PG8_LAS unsigned*)(lds + (bufoff) + ldsw + _i * 8192), 16, 0, 0); } while (0)
#define PG8_LDA(dst, b, h) do { _Pragma("unroll") for (int m = 0; m < 4; ++m) _Pragma("unroll") for (int k = 0; k < 2; ++k) dst[m][k] = *(const PG8_LAS bf16x8*)(lds + PG8_SA(b, h) + aoff + m * 2048 + k * 1024); } while (0)
#define PG8_LDB(dst, b, h) do { _Pragma("unroll") for (int n = 0; n < 2; ++n) _Pragma("unroll") for (int k = 0; k < 2; ++k) dst[n][k] = *(const PG8_LAS bf16x8*)(lds + PG8_SB(b, h) + boff + n * 2048 + k * 1024); } while (0)
#define PG8_MMA(ai, bj, At, Bt) do { __builtin_amdgcn_s_setprio(1); _Pragma("unroll") for (int m = 0; m < 4; ++m) _Pragma("unroll") for (int n = 0; n < 2; ++n) _Pragma("unroll") for (int k = 0; k < 2; ++k) \
        acc[ai][bj][m][n] = __builtin_amdgcn_mfma_f32_16x16x32_bf16(Bt[n][k], At[m][k], acc[ai][bj][m][n], 0, 0, 0); __builtin_amdgcn_s_setprio(0); } while (0)
#define PG8_WAIT_V(n) asm volatile("s_waitcnt vmcnt(" #n ")" ::: "memory")
#define PG8_WAIT_L(n) asm volatile("s_waitcnt lgkmcnt(" #n ")" ::: "memory")
#define PG8_BAR __builtin_amdgcn_s_barrier()
#define PG8_SCHED __builtin_amdgcn_sched_barrier(0)
    Unit cur, nxt; int ui = 0;
    if (!S.next(0, cur)) return;
    f32x4 acc[2][2][4][2];
#pragma unroll
    for (int a = 0; a < 2; ++a)
#pragma unroll
        for (int b = 0; b < 2; ++b)
#pragma unroll
            for (int m = 0; m < 4; ++m)
#pragma unroll
                for (int n = 0; n < 2; ++n) acc[a][b][m][n] = (f32x4){0.f, 0.f, 0.f, 0.f};
    bf16x8 At[4][2], B0[2][2], B1[2][2];
    const char* cA = (const char*)g.A + (size_t)cur.pm * tstepA; const char* cB = (const char*)g.Bt + (size_t)cur.pn * tstepB;
    S.a_ready(cur);
    if constexpr (SP2) {
        PG8_STAGE(PG8_SB(0, 0), cB, voffB); PG8_STAGE(PG8_SB(0, 1), cB + hstepB, voffB); PG8_STAGE(PG8_SA(0, 0), cA, voffA); PG8_STAGE(PG8_SA(0, 1), cA + hstepA, voffA);
        if (wr == 1) PG8_BAR;
        PG8_WAIT_V(2); PG8_BAR;
        PG8_STAGE(PG8_SB(1, 0), cB + kstep, voffB); PG8_STAGE(PG8_SA(1, 0), cA + kstep, voffA); PG8_STAGE(PG8_SB(1, 1), cB + hstepB + kstep, voffB);
        PG8_WAIT_V(6); PG8_BAR;
    } else {
        PG8_STAGE(PG8_SB(0, 0), cB, voffB); PG8_STAGE(PG8_SA(0, 0), cA, voffA); PG8_STAGE(PG8_SB(0, 1), cB + hstepB, voffB); PG8_STAGE(PG8_SA(0, 1), cA + hstepA, voffA);
        if (wr == 1) PG8_BAR;
        PG8_WAIT_V(4); PG8_BAR;
        PG8_STAGE(PG8_SB(1, 0), cB + kstep, voffB); PG8_STAGE(PG8_SA(1, 0), cA + kstep, voffA); PG8_STAGE(PG8_SB(1, 1), cB + hstepB + kstep, voffB);
        PG8_WAIT_V(6); PG8_BAR;
    }
    for (;;) {
        const bool has_next = S.next(ui + 1, nxt);
        const char* nA = has_next ? (const char*)g.A + (size_t)nxt.pm * tstepA : cA; const char* nB = has_next ? (const char*)g.Bt + (size_t)nxt.pn * tstepB : cB;
        for (int t = 0; t < nt; t += 2) {
            if constexpr (Epi::MIDK > 0) { if (t > 0 && t <= Epi::MIDK && (t % Epi::MIDSTEP) == 0) E.mid(acc, cur, t, wr, wc, fr, fq); }
            const bool last = (t == nt - 2);
            const char* a1 = cA + (size_t)(t + 1) * kstep;
            const char* a2 = last ? nA : cA + (size_t)(t + 2) * kstep; const char* b2 = last ? nB : cB + (size_t)(t + 2) * kstep;
            const char* a3 = a2 + kstep; const char* b3 = b2 + kstep;
            if (last && has_next) S.a_ready(nxt);
            if constexpr (SP2) {
            PG8_LDB(B0, 0, 0); PG8_LDB(B1, 0, 1); PG8_SCHED; PG8_LDA(At, 0, 0); PG8_STAGE(PG8_SA(1, 1), a1 + hstepA, voffA);
            PG8_WAIT_V(8); PG8_WAIT_L(0); PG8_BAR; PG8_MMA(0, 0, At, B0); PG8_MMA(0, 1, At, B1); PG8_BAR; PG8_SCHED;
            PG8_LDA(At, 0, 1); PG8_STAGE(PG8_SB(0, 0), b2, voffB); PG8_STAGE(PG8_SB(0, 1), b2 + hstepB, voffB); PG8_STAGE(PG8_SA(0, 0), a2, voffA);
            PG8_WAIT_V(8); PG8_WAIT_L(0); PG8_BAR; PG8_MMA(1, 0, At, B0); PG8_MMA(1, 1, At, B1); PG8_BAR; PG8_SCHED;
            PG8_LDB(B0, 1, 0); PG8_LDB(B1, 1, 1); PG8_SCHED; PG8_LDA(At, 1, 0); PG8_STAGE(PG8_SA(0, 1), a2 + hstepA, voffA);
            PG8_WAIT_V(8); PG8_WAIT_L(0); PG8_BAR; PG8_MMA(0, 0, At, B0); PG8_MMA(0, 1, At, B1); PG8_BAR; PG8_SCHED;
            PG8_LDA(At, 1, 1); PG8_STAGE(PG8_SB(1, 0), b3, voffB); PG8_STAGE(PG8_SB(1, 1), b3 + hstepB, voffB); PG8_STAGE(PG8_SA(1, 0), a3, voffA);
            PG8_WAIT_V(8); PG8_WAIT_L(0); PG8_BAR; PG8_MMA(1, 0, At, B0); PG8_MMA(1, 1, At, B1); PG8_BAR; PG8_SCHED;
            } else {
            PG8_LDB(B0, 0, 0); PG8_SCHED; PG8_LDA(At, 0, 0); PG8_STAGE(PG8_SA(1, 1), a1 + hstepA, voffA);
            PG8_WAIT_L(8); PG8_BAR; PG8_WAIT_L(0); PG8_MMA(0, 0, At, B0); PG8_BAR; PG8_SCHED;
            PG8_LDB(B1, 0, 1); PG8_STAGE(PG8_SB(0, 0), b2, voffB);
            PG8_BAR; PG8_WAIT_L(0); PG8_MMA(0, 1, At, B1); PG8_BAR;
            PG8_LDA(At, 0, 1); PG8_STAGE(PG8_SA(0, 0), a2, voffA);
            PG8_BAR; PG8_WAIT_L(0); PG8_MMA(1, 0, At, B0); PG8_BAR; PG8_SCHED;
            PG8_STAGE(PG8_SB(0, 1), b2 + hstepB, voffB);
            PG8_WAIT_V(6); PG8_BAR; PG8_MMA(1, 1, At, B1); PG8_BAR;
            PG8_LDB(B0, 1, 0); PG8_SCHED; PG8_LDA(At, 1, 0); PG8_STAGE(PG8_SA(0, 1), a2 + hstepA, voffA);
            PG8_WAIT_L(8); PG8_BAR; PG8_WAIT_L(0); PG8_MMA(0, 0, At, B0); PG8_BAR; PG8_SCHED;
            PG8_LDB(B1, 1, 1); PG8_STAGE(PG8_SB(1, 0), b3, voffB);
            PG8_BAR; PG8_WAIT_L(0); PG8_MMA(0, 1, At, B1); PG8_BAR;
            PG8_LDA(At, 1, 1); PG8_STAGE(PG8_SA(1, 0), a3, voffA);
            PG8_BAR; PG8_WAIT_L(0); PG8_MMA(1, 0, At, B0); PG8_BAR; PG8_SCHED;
            PG8_STAGE(PG8_SB(1, 1), b3 + hstepB, voffB);
            PG8_WAIT_V(6); PG8_BAR; PG8_MMA(1, 1, At, B1); PG8_BAR;
            }
        }
        if constexpr (ALIGN_EPI) { if (wr == 0) PG8_BAR; }
        if constexpr (!Epi::AFTER_DRAIN) { E(acc, cur, wr, wc, fr, fq); S.done(cur); }
        if (!has_next) break;
#pragma unroll
        for (int a = 0; a < 2; ++a)
#pragma unroll
            for (int b = 0; b < 2; ++b)
#pragma unroll
                for (int m = 0; m < 4; ++m)
#pragma unroll
                    for (int n = 0; n < 2; ++n) acc[a][b][m][n] = (f32x4){0.f, 0.f, 0.f, 0.f};
        cur = nxt; cA = nA; cB = nB; ++ui;
        if constexpr (ALIGN_EPI) { if (wr == 1) PG8_BAR; }
    }
    PG8_WAIT_V(0);
    if constexpr (!ALIGN_EPI) { if (wr == 0) PG8_BAR; }
    PG8_BAR;
    if constexpr (Epi::AFTER_DRAIN) { E.fused(acc, cur, wr, wc, fr, fq, lds, wid, lane); S.done(cur); }
#undef PG8_SA
#undef PG8_SB
#undef PG8_STAGE
#undef PG8_LDA
#undef PG8_LDB
#undef PG8_MMA
#undef PG8_WAIT_V
#undef PG8_WAIT_L
#undef PG8_BAR
#undef PG8_SCHED
}
}

constexpr int NWAVES = 8;
constexpr int BATCH = 16, SEQ = 2048, D = 1024, M = BATCH * SEQ, FF = 4096;
constexpr int LDP = 6656;
constexpr int C_Q = 0, C_K = 512, C_OG = 1024, C_GV = 2048, C_RV = 3072, C_RR = 4096, C_RK = 5120, C_WL = 6144, C_AL = 6208, C_GL = 6272, C_GAL = 6400, NA_VALID = 6416, NA = 6656, NG = 2048;
constexpr int C_MIX = 0, C_A2 = 1024, C_H = 2048, C_SG = 4096;
constexpr float NORM_EPS = 1e-6f, GLA_NORM_EPS = 1e-5f, RWKV_GN_EPS = 64e-5f;

constexpr size_t MiB = 1u << 20;
constexpr size_t WS_CTL = 0, CTL_ZERO_BYTES = (8192 + 16 * 4096) * 4;
constexpr size_t WS_WIN = 2 * MiB;
constexpr size_t WS_WBR = 20 * MiB;
constexpr size_t WS_WOUT = 24 * MiB;
constexpr size_t WS_WUP = 26 * MiB;
constexpr size_t WS_WDN = 34 * MiB;
constexpr size_t WS_LW = 42 * MiB;
constexpr size_t WS_LA = WS_LW + 131072;
constexpr size_t WS_LG = WS_LA + 131072;
constexpr size_t WS_GS = 43 * MiB;
constexpr size_t WS_SQ1 = 45 * MiB;
constexpr size_t WS_SQ2 = 47 * MiB;
constexpr size_t WS_P = 64 * MiB;
constexpr size_t WS_LIN = WS_P + (size_t)M * LDP * 2;
constexpr size_t WS_END = WS_LIN + (size_t)M * 256 * 2;
static_assert(WS_END <= 512 * MiB, "d_ws map");
constexpr int CW_BAR = 4096;
constexpr int CW_GBAR = 8192;
#ifndef NGRP
#define NGRP 2
#endif
constexpr int GSZ = 256 / NGRP, GROWS = M / NGRP;
static_assert(256 % NGRP == 0 && 16 % NGRP == 0 && NGRP <= 16, "groups own whole batches");
constexpr int CW_PAN = 16384;

constexpr int LDS_BYTES = 160 * 1024;
constexpr int MISC_OFF = LDS_BYTES - 256;

#define GAS __attribute__((address_space(1)))
#define LAS __attribute__((address_space(3)))
typedef unsigned short bf16;
typedef unsigned v4u __attribute__((ext_vector_type(4)));
typedef unsigned v2u __attribute__((ext_vector_type(2)));
typedef float f32x4 __attribute__((ext_vector_type(4)));
typedef short bf16x8 __attribute__((ext_vector_type(8)));
typedef GAS unsigned gu32;
#define RLX_AGENT __ATOMIC_RELAXED, __HIP_MEMORY_SCOPE_AGENT
#define LDS_WAIT() asm volatile("s_waitcnt lgkmcnt(0)" ::: "memory")
#define VM_WAIT() asm volatile("s_waitcnt vmcnt(0)" ::: "memory")
__device__ __forceinline__ unsigned f2bf(float f) { unsigned u = __builtin_bit_cast(unsigned, f); return (u + 0x7fffu + ((u >> 16) & 1u)) >> 16; }
typedef float f32x2_t __attribute__((ext_vector_type(2))); typedef __bf16 bf16x2_t __attribute__((ext_vector_type(2)));
__device__ __forceinline__ unsigned pk2(float lo, float hi) { const f32x2_t v = {lo, hi}; return __builtin_bit_cast(unsigned, __builtin_convertvector(v, bf16x2_t)); }
__device__ __forceinline__ float bflo(unsigned w) { return __uint_as_float(w << 16); }
__device__ __forceinline__ float bfhi(unsigned w) { return __uint_as_float(w & 0xffff0000u); }
__device__ __forceinline__ void unpack8(const v4u w, float (&o)[8]) { o[0] = bflo(w.x); o[1] = bfhi(w.x); o[2] = bflo(w.y); o[3] = bfhi(w.y); o[4] = bflo(w.z); o[5] = bfhi(w.z); o[6] = bflo(w.w); o[7] = bfhi(w.w); }
__device__ __forceinline__ v4u pack8(const float (&v)[8]) { v4u w; w.x = pk2(v[0], v[1]); w.y = pk2(v[2], v[3]); w.z = pk2(v[4], v[5]); w.w = pk2(v[6], v[7]); return w; }
__device__ __forceinline__ float fexp(float x) { return __builtin_amdgcn_exp2f(1.4426950408889634f * x); }
__device__ __forceinline__ float fsig(float x) { return __builtin_amdgcn_rcpf(1.0f + fexp(-x)); }
__device__ __forceinline__ float fsoftplus(float x) { return fmaxf(x, 0.f) + __logf(1.0f + fexp(-fabsf(x))); }
__device__ __forceinline__ float add8(float x) {
    x += __int_as_float(__builtin_amdgcn_update_dpp(0, __float_as_int(x), 0xB1, 0xf, 0xf, false));
    x += __int_as_float(__builtin_amdgcn_update_dpp(0, __float_as_int(x), 0x4E, 0xf, 0xf, false));
    x += __int_as_float(__builtin_amdgcn_update_dpp(0, __float_as_int(x), 0x141, 0xf, 0xf, false));
    return x;
}
__device__ __forceinline__ bf16x8 lfrag(const LAS bf16* base, int ld, int r0, int k0, int lane) { return *(const LAS bf16x8*)(base + (r0 + (lane & 15)) * ld + k0 + 8 * (lane >> 4)); }
__device__ __forceinline__ bf16x8 gfrag(const bf16* base, int ld, int r0, int k0, int lane) { return *(const bf16x8*)(base + (size_t)(r0 + (lane & 15)) * ld + k0 + 8 * (lane >> 4)); }
#define MFMA16(a, b, c) __builtin_amdgcn_mfma_f32_16x16x32_bf16((a), (b), (c), 0, 0, 0)

#define XB_TMO      128
#define XB_XCNT(j)  (256  + 64 * (j))
#define XB_XSUB(j)  (1280 + 64 * (j))
#define XB_XGEN(j)  (2304 + 64 * (j))
#define XB_TOP      3328
#define XB_TOPGEN   3392
#define XCD_BAR_WORDS 3456
#define XB_SPIN_CAP (1u << 18)

__device__ __forceinline__ unsigned xb_ld(unsigned* p)              { return __hip_atomic_load(p, __ATOMIC_RELAXED, __HIP_MEMORY_SCOPE_AGENT); }
__device__ __forceinline__ unsigned xb_add(unsigned* p, unsigned v) { return __hip_atomic_fetch_add(p, v, __ATOMIC_RELAXED, __HIP_MEMORY_SCOPE_AGENT); }
__device__ __forceinline__ unsigned xb_xcc_id() { return (unsigned)__builtin_amdgcn_s_getreg((3 << 11) | 20) & 0xFu; }
#define XB_SPIN(cond, bar) do { unsigned _sp = 0; while (cond) { __builtin_amdgcn_s_sleep(1); \
    if ((++_sp & 255u) == 0u) { if (xb_ld(&(bar)[XB_TMO])) break; if (_sp > XB_SPIN_CAP) { atomicAdd(&(bar)[XB_TMO], 1u); break; } } } } while (0)

struct XcdBarrier {
    unsigned* bar; unsigned x, tot;
    volatile LAS unsigned* st;
};

__device__ __forceinline__ XcdBarrier xcd_barrier_post(unsigned* bar, volatile LAS unsigned* st, unsigned tot) {
    XcdBarrier b; b.bar = bar; b.x = xb_xcc_id(); b.st = st; b.tot = tot;
    if (threadIdx.x == 0) (void)xb_add(&bar[XB_XCNT(b.x)], 1u);
    return b;
}
__device__ __forceinline__ void xcd_barrier_complete(unsigned* bar, unsigned x, unsigned G, unsigned& nloc, unsigned& nx) {
    unsigned sum, cnt, mine, sp = 0u;
    for (;;) {
        sum = 0u; cnt = 0u; mine = 0u;
#pragma unroll
        for (unsigned j = 0; j < 16; ++j) { const unsigned c = xb_ld(&bar[XB_XCNT(j)]); sum += c; cnt += (c > 0u) ? 1u : 0u; mine = (j == x) ? c : mine; }
        if (sum == G) break;
        __builtin_amdgcn_s_sleep(1);
        if ((++sp & 255u) == 0u) { if (xb_ld(&bar[XB_TMO])) break; if (sp > XB_SPIN_CAP) { atomicAdd(&bar[XB_TMO], 1u); break; } }
    }
    nloc = mine > 0u ? mine : 1u; nx = cnt > 0u ? cnt : 1u;
}

__device__ __forceinline__ void xcd_barrier(const XcdBarrier& b) {
    asm volatile("s_waitcnt vmcnt(0)" ::: "memory");
    __syncthreads();
    if (threadIdx.x == 0) {
        unsigned* bar = b.bar;
        __builtin_amdgcn_s_waitcnt(0);
        unsigned nloc = b.st[0], nx = b.st[1];
        if (nloc == 0u) { xcd_barrier_complete(bar, b.x, b.tot, nloc, nx); b.st[0] = nloc; b.st[1] = nx; }
        const unsigned old = xb_add(&bar[XB_XSUB(b.x)], 1u);
        const unsigned gen = old / nloc;
        if (old + 1u == (gen + 1u) * nloc) {
            __builtin_amdgcn_fence(__ATOMIC_RELEASE, "agent");
            asm volatile("s_waitcnt vmcnt(0)" ::: "memory");
            const unsigned og = xb_add(&bar[XB_TOP], 1u);
            const unsigned tg = og / nx;
            if (og + 1u == (tg + 1u) * nx) xb_add(&bar[XB_TOPGEN], 1u);
            else XB_SPIN(xb_ld(&bar[XB_TOPGEN]) == tg, bar);
            __builtin_amdgcn_fence(__ATOMIC_ACQUIRE, "agent");
            xb_add(&bar[XB_XGEN(b.x)], 1u);
            asm volatile("s_waitcnt vmcnt(0)" ::: "memory");
        } else {
            XB_SPIN(xb_ld(&bar[XB_XGEN(b.x)]) == gen, bar);
            __builtin_amdgcn_fence(__ATOMIC_ACQUIRE, "agent");
            asm volatile("s_waitcnt vmcnt(0)" ::: "memory");
        }
    }
    __syncthreads();
}

struct Frame {
    LAS unsigned char* lds;
    volatile LAS unsigned* MISC;
    gu32* ctl;
    int tid, lane, wave;
    int vcu, G;
    int gid, lc, cg;
    const float* in[24]; float* out;
    bf16 *WIN, *WBR, *WOUT, *WUP, *WDN, *LW, *LA, *LG, *P, *XN, *LIN;
    float *GS, *SQ1, *SQ2;
};
enum { I_X = 0, I_NORM_MIX, I_W_IN, I_GLA_A_W2, I_GLA_A_B, I_GLA_NORM, I_MU, I_W0, I_W_W2, I_A0, I_A_W2, I_G_W2, I_K_K, I_K_A, I_R_K, I_LN_W, I_LN_B, I_WB_GLA, I_WB_RWKV, I_W_OUT, I_NORM_MLP, I_W_UP, I_W_DOWN, I_NORM_FINAL };

__device__ __forceinline__ float wave_sum(float v) {
#pragma unroll
    for (int o = 1; o < 64; o <<= 1) v += __shfl_xor(v, o);
    return v;
}
__device__ __forceinline__ int win_src_col(int n) {
    if (n < 1024) return n;
    if (n < 2048) return n + 1024;
    if (n < 3072) return n - 1024;
    if (n < 4096) return n - 3072 + 5136;
    if (n < 6144) return n - 4096 + 3088;
    if (n < 6400) return n - 6144 + 6160;
    if (n < 6416) return n - 6400 + 3072;
    if (n < 6656) return -1;
    return n - 6656 + 6416;
}
__device__ __forceinline__ void tr_item(const float* W, int Nsrc, int sc4, int k0, const float* gk, bf16* WT, int ldk, int drow, int dk0, LAS float* scr, int lane) {
    const int r8 = lane >> 3, c4 = (lane & 7) * 4;
    f32x4 v[8];
#pragma unroll
    for (int i = 0; i < 8; ++i) { const int kk = 8 * i + r8;
        v[i] = (sc4 >= 0) ? *(const f32x4*)(W + (size_t)(k0 + kk) * Nsrc + sc4) : (f32x4){0.f, 0.f, 0.f, 0.f}; }
#pragma unroll
    for (int i = 0; i < 8; ++i) { const int kk = 8 * i + r8; f32x4 x = v[i]; if (gk) x = x * gk[k0 + kk];
        scr[kk * 33 + c4] = x[0]; scr[kk * 33 + c4 + 1] = x[1]; scr[kk * 33 + c4 + 2] = x[2]; scr[kk * 33 + c4 + 3] = x[3]; }
    LDS_WAIT(); asm volatile("" ::: "memory");
    const int c = lane & 7;
#pragma unroll
    for (int j = 0; j < 4; ++j) { const int n = (lane >> 3) + 8 * j; const LAS float* s = scr + (8 * c) * 33 + n;
        v4u o; o.x = pk2(s[0 * 33], s[1 * 33]); o.y = pk2(s[2 * 33], s[3 * 33]); o.z = pk2(s[4 * 33], s[5 * 33]); o.w = pk2(s[6 * 33], s[7 * 33]);
        *(GAS v4u*)(WT + (size_t)(drow + n) * ldk + dk0 + k0 + 8 * c) = o; }
    LDS_WAIT(); asm volatile("" ::: "memory");
}
__device__ __forceinline__ void p0_prologue(Frame& F) {
    LAS float* scr = (LAS float*)(F.lds + F.wave * 16384);
    const int gw = F.vcu * NWAVES + F.wave, NGW = F.G * NWAVES, lane = F.lane;
    constexpr int I_WIN = 16 * 272, I_B = 16 * 32, I_UP = 16 * 128, I_DN = 64 * 32, I_L64 = 32, I_L128 = 64;
    constexpr int NITEMS = I_WIN + 3 * I_B + I_UP + I_DN + 2 * I_L64 + I_L128;
    for (int it = gw; it < NITEMS; it += NGW) {
        int r = it;
        if (r < I_WIN) { const int kb = r / 272, nb = r % 272; tr_item(F.in[I_W_IN], 8464, win_src_col(32 * nb + ((lane & 7) * 4)), 64 * kb, nullptr, F.WIN, 1024, 32 * nb, 0, scr, lane); continue; } r -= I_WIN;
        if (r < I_B) { const int kb = r / 32, nb = r % 32; tr_item(F.in[I_WB_GLA], 1024, 32 * nb + ((lane & 7) * 4), 64 * kb, nullptr, F.WBR, 2048, 32 * nb, 0, scr, lane); continue; } r -= I_B;
        if (r < I_B) { const int kb = r / 32, nb = r % 32; tr_item(F.in[I_WB_RWKV], 1024, 32 * nb + ((lane & 7) * 4), 64 * kb, nullptr, F.WBR, 2048, 32 * nb, 1024, scr, lane); continue; } r -= I_B;
        if (r < I_B) { const int kb = r / 32, nb = r % 32; tr_item(F.in[I_W_OUT], 1024, 32 * nb + ((lane & 7) * 4), 64 * kb, nullptr, F.WOUT, 1024, 32 * nb, 0, scr, lane); continue; } r -= I_B;
        if (r < I_UP) { const int kb = r / 128, nb = r % 128; tr_item(F.in[I_W_UP], 4096, 32 * nb + ((lane & 7) * 4), 64 * kb, F.in[I_NORM_MLP], F.WUP, 1024, 32 * nb, 0, scr, lane); continue; } r -= I_UP;
        if (r < I_DN) { const int kb = r / 32, nb = r % 32; tr_item(F.in[I_W_DOWN], 1024, 32 * nb + ((lane & 7) * 4), 64 * kb, nullptr, F.WDN, 4096, 32 * nb, 0, scr, lane); continue; } r -= I_DN;
        if (r < I_L64) { tr_item(F.in[I_W_W2], 1024, 32 * r + ((lane & 7) * 4), 0, nullptr, F.LW, 64, 32 * r, 0, scr, lane); continue; } r -= I_L64;
        if (r < I_L64) { tr_item(F.in[I_A_W2], 1024, 32 * r + ((lane & 7) * 4), 0, nullptr, F.LA, 64, 32 * r, 0, scr, lane); continue; } r -= I_L64;
        { const int kb = r / 32, nb = r % 32; tr_item(F.in[I_G_W2], 1024, 32 * nb + ((lane & 7) * 4), 64 * kb, nullptr, F.LG, 128, 32 * nb, 0, scr, lane); }
    }
    const float* x = F.in[I_X]; const float* g = F.in[I_NORM_MIX];
    f32x4 gv[4];
#pragma unroll
    for (int j = 0; j < 4; ++j) gv[j] = ((const f32x4*)g)[lane + 64 * j];
    for (int m = gw; m < M; m += 4 * NGW) {
        f32x4 v[4][4]; float ss[4];
#pragma unroll
        for (int u = 0; u < 4; ++u) { const GAS f32x4* xr = (const GAS f32x4*)(x + (size_t)(m + u * NGW) * D) + lane;
#pragma unroll
            for (int j = 0; j < 4; ++j) v[u][j] = xr[64 * j]; }
#pragma unroll
        for (int u = 0; u < 4; ++u) { float s0 = 0.f;
#pragma unroll
            for (int j = 0; j < 4; ++j) s0 += (v[u][j].x * v[u][j].x + v[u][j].y * v[u][j].y) + (v[u][j].z * v[u][j].z + v[u][j].w * v[u][j].w);
            ss[u] = s0; }
#pragma unroll
        for (int o = 1; o < 64; o <<= 1) {
#pragma unroll
            for (int u = 0; u < 4; ++u) ss[u] += __shfl_xor(ss[u], o); }
#pragma unroll
        for (int u = 0; u < 4; ++u) { const float rs = __builtin_amdgcn_rsqf(ss[u] * (1.f / D) + NORM_EPS);
            const int mr = m + u * NGW; GAS v2u* o8 = (GAS v2u*)(F.XN + (size_t)(mr / GROWS) * GROWS * 2048 + (size_t)(mr % GROWS) * D) + lane;
#pragma unroll
            for (int j = 0; j < 4; ++j) { v2u w; w.x = pk2(v[u][j].x * rs * gv[j].x, v[u][j].y * rs * gv[j].y); w.y = pk2(v[u][j].z * rs * gv[j].z, v[u][j].w * rs * gv[j].w); o8[64 * j] = w; } }
    }
}

__device__ __forceinline__ bf16x8 dfrag(const f32x4 d) {
    const unsigned lo = pk2(d[0], d[1]), hi = pk2(d[2], d[3]); v4u w = {lo, hi, 0u, 0u}; return __builtin_bit_cast(bf16x8, w); }
__device__ __forceinline__ bf16x8 dfrag2(const f32x4 d0, const f32x4 d1) {
    v4u w = {pk2(d0[0], d0[1]), pk2(d0[2], d0[3]), pk2(d1[0], d1[1]), pk2(d1[2], d1[3])}; return __builtin_bit_cast(bf16x8, w); }
__device__ __forceinline__ bf16x8 pfrag(const LAS bf16* base, int ld, int row0, int col0, int col1, int lane) {
    const LAS bf16* p = base + (row0 + (lane & 15)) * ld + 4 * (lane >> 4);
    const v2u a = *(const LAS v2u*)(p + col0), b = *(const LAS v2u*)(p + col1); v4u w = {a.x, a.y, b.x, b.y}; return __builtin_bit_cast(bf16x8, w); }
__device__ __forceinline__ bf16x8 pfrag1(const LAS bf16* base, int ld, int row0, int col0, int lane) {
    const v2u a = *(const LAS v2u*)(base + (row0 + (lane & 15)) * ld + 4 * (lane >> 4) + col0); v4u w = {a.x, a.y, 0u, 0u}; return __builtin_bit_cast(bf16x8, w); }
__device__ __forceinline__ float ldbf(const LAS bf16* p) { return __uint_as_float(((unsigned)*p) << 16); }


typedef short s16x4 __attribute__((ext_vector_type(4)));
__device__ __forceinline__ s16x4 trd4(const LAS bf16* img, int ld, int row, int col0, int lane) {
    const int i = lane & 15; return __builtin_amdgcn_ds_read_tr16_b64_v4i16((LAS s16x4*)(img + (row + (i >> 2)) * ld + col0 + 4 * (i & 3))); }
__device__ __forceinline__ bf16x8 trfrag(const LAS bf16* img, int ld, int rowA, int rowB, int col0, int lane) {
    const s16x4 a = trd4(img, ld, rowA, col0, lane), b = trd4(img, ld, rowB, col0, lane); return (bf16x8){a[0], a[1], a[2], a[3], b[0], b[1], b[2], b[3]}; }
__device__ __forceinline__ bf16x8 trfrag1(const LAS bf16* img, int ld, int rowA, int col0, int lane) {
    const s16x4 a = trd4(img, ld, rowA, col0, lane); return (bf16x8){a[0], a[1], a[2], a[3], 0, 0, 0, 0}; }
__device__ __forceinline__ f32x4 tr2f(const s16x4 a) { return (f32x4){__uint_as_float(((unsigned)(unsigned short)a[0]) << 16), __uint_as_float(((unsigned)(unsigned short)a[1]) << 16), __uint_as_float(((unsigned)(unsigned short)a[2]) << 16), __uint_as_float(((unsigned)(unsigned short)a[3]) << 16)}; }

__device__ __forceinline__ void rwkv_item(Frame& F, int item, bool dry = false) {
    const int b = item >> 4, h = item & 15, tid = F.tid, wave = F.wave;
    LAS unsigned char* L = F.lds;
    LAS bf16* sAt = (LAS bf16*)L; LAS bf16* sRt = sAt + 4608; LAS bf16* sBt = sRt + 4608; LAS bf16* sKt = sBt + 4608;
    LAS bf16* sBh = sKt + 4608; LAS bf16* sKh = sBh + 4608; LAS bf16* sV = sKh + 4608;
    LAS bf16* sAabT = sV + 4608; LAS bf16* sAakT = sAabT + 4608; LAS bf16* sArbT = sAakT + 4608; LAS bf16* sArkT = sArbT + 4608;
    LAS float* sLW = (LAS float*)(sArkT + 4608); LAS float* sY = (LAS float*)sBt;
    LAS bf16* sWA = (LAS bf16*)sLW; LAS bf16* sGL = sWA + 8704;
    LAS float* sAa = sLW + 4352; LAS float* sG = sAa + 4352;
    LAS float* sTot = sG + 4352; LAS float* sBonus = sTot + 512; LAS float* sVlast = sBonus + 64; LAS float* sGam = sVlast + 128;
    LAS float* sC = sGam + 64;
    const int t = tid >> 3, kb = tid & 7, hc0 = h * 64 + kb * 8;
    {   const float* mu = F.in[I_MU];
        if (tid < 64) { const int ch = h * 64 + tid;
            sC[tid] = mu[ch]; sC[64 + tid] = mu[1024 + ch]; sC[128 + tid] = mu[2048 + ch]; sC[192 + tid] = F.in[I_K_K][ch]; sC[256 + tid] = F.in[I_K_A][ch];
            sC[320 + tid] = F.in[I_R_K][ch]; sC[384 + tid] = F.in[I_LN_W][ch]; sC[448 + tid] = F.in[I_LN_B][ch]; sC[512 + tid] = mu[3072 + tid]; sC[576 + tid] = mu[3136 + tid]; }
        else if (tid < 192) sC[640 + tid - 64] = mu[3200 + tid - 64];
    }
    const int wci = wave & 3;
    bf16x8 fLW[2], fLA[2], fLG[4]; float w0c = 0.f, a0c = 0.f;
    if (wave < 4) { w0c = F.in[I_W0][h * 64 + wci * 16 + (F.lane & 15)]; a0c = F.in[I_A0][h * 64 + wci * 16 + (F.lane & 15)]; }
#define RWKV_LORA_W(LANEV) do { \
        _Pragma("unroll") for (int ks = 0; ks < 2; ++ks) { fLW[ks] = gfrag(F.LW, 64, h * 64 + wci * 16, ks * 32, LANEV); fLA[ks] = gfrag(F.LA, 64, h * 64 + wci * 16, ks * 32, LANEV); } \
        _Pragma("unroll") for (int ks = 0; ks < 4; ++ks) fLG[ks] = gfrag(F.LG, 128, h * 64 + wci * 16, ks * 32, LANEV); } while (0)
    f32x4 loW[4], loA[4];
#pragma unroll
    for (int i = 0; i < 4; ++i) { loW[i] = (f32x4){0.f, 0.f, 0.f, 0.f}; loA[i] = loW[i]; }
#define RWKV_LORA(LANEV, CLV, G4V) do { f32x4 lwv_[4]; \
        _Pragma("unroll") for (int ti = 0; ti < 4; ++ti) { f32x4 accw_ = {0.f, 0.f, 0.f, 0.f}, acca_ = accw_, accg_ = accw_; \
            _Pragma("unroll") for (int ks = 0; ks < 2; ++ks) { accw_ = MFMA16(lfrag(sWA, 136, ti * 16, ks * 32, LANEV), fLW[ks], accw_); acca_ = MFMA16(lfrag(sWA, 136, ti * 16, 64 + ks * 32, LANEV), fLA[ks], acca_); } \
            _Pragma("unroll") for (int ks = 0; ks < 4; ++ks) accg_ = MFMA16(lfrag(sGL, 136, ti * 16, ks * 32, LANEV), fLG[ks], accg_); \
            _Pragma("unroll") for (int j = 0; j < 4; ++j) { lwv_[ti][j] = -0.6065306597126334f * fsig(w0c + accw_[j]); loA[ti][j] = fsig(a0c + acca_[j]); sG[(ti * 16 + G4V * 4 + j) * 68 + wci * 16 + CLV] = accg_[j]; } } \
        float base_ = 0.f; \
        _Pragma("unroll") for (int ti = 0; ti < 4; ++ti) { lwv_[ti][1] += lwv_[ti][0]; lwv_[ti][2] += lwv_[ti][1]; lwv_[ti][3] += lwv_[ti][2]; const float sg_ = lwv_[ti][3]; \
            const float s0_ = __shfl(sg_, CLV), s1_ = __shfl(sg_, CLV + 16), s2_ = __shfl(sg_, CLV + 32), s3_ = __shfl(sg_, CLV + 48); \
            const float ex_ = base_ + ((G4V > 0) ? s0_ : 0.f) + ((G4V > 1) ? s1_ : 0.f) + ((G4V > 2) ? s2_ : 0.f); base_ += (s0_ + s1_) + (s2_ + s3_); \
            _Pragma("unroll") for (int j = 0; j < 4; ++j) loW[ti][j] = lwv_[ti][j] + ex_; } } while (0)
    f32x4 Hs[4];
#pragma unroll
    for (int i = 0; i < 4; ++i) Hs[i] = (f32x4){0.f, 0.f, 0.f, 0.f};
    LAS bf16* sEx = (LAS bf16*)(sC + 768);
    if (tid < 48) ((LAS v4u*)(sEx + 7 * 192))[tid] = (v4u){0u, 0u, 0u, 0u};
    v4u pr, pk, pv, pwl, pal, pg0, pg1;
    {   const size_t mrow = (size_t)b * SEQ + t; const bf16* row = F.P + mrow * LDP; const bf16* lin = F.LIN + mrow * 256;
        pr = *(const v4u*)(row + C_RR + hc0); pk = *(const v4u*)(row + C_RK + hc0); pv = *(const v4u*)(row + C_RV + hc0);
        pwl = *(const v4u*)(lin + kb * 8); pal = *(const v4u*)(lin + 64 + kb * 8); pg0 = *(const v4u*)(lin + 128 + kb * 8); pg1 = *(const v4u*)(lin + 192 + kb * 8); }
    *(LAS v4u*)(sWA + t * 136 + kb * 8) = pwl; *(LAS v4u*)(sWA + t * 136 + 64 + kb * 8) = pal; *(LAS v4u*)(sGL + t * 136 + kb * 8) = pg0; *(LAS v4u*)(sGL + t * 136 + 64 + kb * 8) = pg1;
    if (wave < 4) RWKV_LORA_W(F.lane);
    __syncthreads();
    if (wave < 4) RWKV_LORA(F.lane, (F.lane & 15), (F.lane >> 4));
    __syncthreads();
    for (int c = 0; c < 32; ++c) {
        const size_t m0 = (size_t)b * SEQ + c * 64;
        int hc = hc0, lane = F.lane; asm volatile("" : "+v"(hc), "+v"(lane));
        const int c8 = hc & 63, cl = lane & 15, g4 = lane >> 4;
        const v4u cr = pr, ck = pk, cv = pv; f32x4 gkeep0, gkeep1;
        if (wave < 4) { const int ch = wci * 16 + cl;
#pragma unroll
            for (int ti = 0; ti < 4; ++ti)
#pragma unroll
                for (int j = 0; j < 4; ++j) { const int o = (ti * 16 + g4 * 4 + j) * 68 + ch; sLW[o] = loW[ti][j]; sAa[o] = loA[ti][j]; } }
        {   LAS bf16* ex = sEx + ((wave < 7) ? wave : 7 + (c & 1)) * 192;
            if ((lane >> 3) == 7) { *(LAS v4u*)(ex + c8) = cr; *(LAS v4u*)(ex + 64 + c8) = ck; *(LAS v4u*)(ex + 128 + c8) = cv; } }
        __syncthreads();
            float rr[8], kr[8], vr[8];
            {   const bool first = (lane >> 3) == 0;
                const LAS bf16* ex = sEx + ((wave == 0) ? (7 + ((c + 1) & 1)) : (wave - 1)) * 192;
                v4u qr, qk, qv;
                qr.x = __shfl_up(cr.x, 8); qr.y = __shfl_up(cr.y, 8); qr.z = __shfl_up(cr.z, 8); qr.w = __shfl_up(cr.w, 8);
                qk.x = __shfl_up(ck.x, 8); qk.y = __shfl_up(ck.y, 8); qk.z = __shfl_up(ck.z, 8); qk.w = __shfl_up(ck.w, 8);
                qv.x = __shfl_up(cv.x, 8); qv.y = __shfl_up(cv.y, 8); qv.z = __shfl_up(cv.z, 8); qv.w = __shfl_up(cv.w, 8);
                if (first) { qr = *(const LAS v4u*)(ex + c8); qk = *(const LAS v4u*)(ex + 64 + c8); qv = *(const LAS v4u*)(ex + 128 + c8); }
                float cu[8], pv8[8];
                unpack8(cr, cu); unpack8(qr, pv8);
#pragma unroll
                for (int j = 0; j < 8; ++j) rr[j] = cu[j] + (pv8[j] - cu[j]) * sC[c8 + j];
                unpack8(ck, cu); unpack8(qk, pv8);
#pragma unroll
                for (int j = 0; j < 8; ++j) kr[j] = cu[j] + (pv8[j] - cu[j]) * sC[64 + c8 + j];
                unpack8(cv, cu); unpack8(qv, pv8);
#pragma unroll
                for (int j = 0; j < 8; ++j) vr[j] = cu[j] + (pv8[j] - cu[j]) * sC[128 + c8 + j];
            }
            if (c < 31) { const size_t mrow = m0 + 64 + t; const bf16* row = F.P + mrow * LDP; const bf16* lin = F.LIN + mrow * 256;
                pr = *(const v4u*)(row + C_RR + hc); pk = *(const v4u*)(row + C_RK + hc); pv = *(const v4u*)(row + C_RV + hc);
                pwl = *(const v4u*)(lin + c8); pal = *(const v4u*)(lin + 64 + c8); pg0 = *(const v4u*)(lin + 128 + c8); pg1 = *(const v4u*)(lin + 192 + c8); }
            float kkr[8], ss = 0.f, bon = 0.f;
#pragma unroll
            for (int j = 0; j < 8; ++j) { kkr[j] = kr[j] * sC[192 + c8 + j]; ss += kkr[j] * kkr[j]; }
            ss = add8(ss); const float inv = __builtin_amdgcn_rsqf(fmaxf(ss, 1e-24f));
        {
            float tot[8];
            {   const f32x4 t0 = *(const LAS f32x4*)(sLW + 63 * 68 + c8), t1 = *(const LAS f32x4*)(sLW + 63 * 68 + c8 + 4);
#pragma unroll
                for (int j = 0; j < 4; ++j) { tot[j] = t0[j]; tot[4 + j] = t1[j]; } }
            float inc[8], pl[8], av[8];
            gkeep0 = *(const LAS f32x4*)(sG + t * 68 + c8); gkeep1 = *(const LAS f32x4*)(sG + t * 68 + c8 + 4);
            {   const f32x4 i0 = *(const LAS f32x4*)(sLW + t * 68 + c8), i1 = *(const LAS f32x4*)(sLW + t * 68 + c8 + 4);
                const f32x4 a0 = *(const LAS f32x4*)(sAa + t * 68 + c8), a1 = *(const LAS f32x4*)(sAa + t * 68 + c8 + 4);
                f32x4 p0 = {0.f, 0.f, 0.f, 0.f}, p1 = p0;
                if (t > 0) { p0 = *(const LAS f32x4*)(sLW + (t - 1) * 68 + c8); p1 = *(const LAS f32x4*)(sLW + (t - 1) * 68 + c8 + 4); }
#pragma unroll
                for (int j = 0; j < 4; ++j) { inc[j] = i0[j]; inc[4 + j] = i1[j]; pl[j] = p0[j]; pl[4 + j] = p1[j]; av[j] = a0[j]; av[4 + j] = a1[j]; } }
            float at[8], rt[8], bt[8], kt[8], bh[8], kh[8], etot[8];
#pragma unroll
            for (int j = 0; j < 8; ++j) etot[j] = fexp(tot[j]);
#pragma unroll
            for (int j = 0; j < 8; ++j) {
                const float gg = inc[j], gp = pl[j];
                const float a = av[j], kk = kkr[j] * inv, kp = kr[j] * (1.0f + (a - 1.0f) * sC[256 + c8 + j]);
                bon += rr[j] * kp * sC[320 + c8 + j];
                const float eg = fexp(gg), egp = fexp(gp), eng = fexp(-gg), ehl = etot[j] * eng, bv = kk * a;
                at[j] = -kk * egp; rt[j] = rr[j] * eg; bt[j] = bv * eng; kt[j] = kp * eng; bh[j] = bv * ehl; kh[j] = kp * ehl;
                if (t == 0) sGam[c8 + j] = etot[j]; }
            {   LAS bf16* tb = sAt;
                *(LAS v4u*)(tb + t * 72 + c8) = pack8(at); *(LAS v4u*)(tb + 4608 + t * 72 + c8) = pack8(rt);
                *(LAS v4u*)(tb + 2 * 4608 + t * 72 + c8) = pack8(bt); *(LAS v4u*)(tb + 3 * 4608 + t * 72 + c8) = pack8(kt); }
            *(LAS v4u*)(sBh + t * 72 + c8) = pack8(bh); *(LAS v4u*)(sKh + t * 72 + c8) = pack8(kh); *(LAS v4u*)(sV + t * 72 + c8) = pack8(vr);
            bon = add8(bon); if (kb == 0) sBonus[t] = bon;
        }
        __syncthreads();
#pragma unroll
        for (int e = 0; e < 8; ++e) { const int q = wave * 8 + e, o = q >> 4, ti = (q >> 2) & 3, si = q & 3;
            LAS bf16* dst = sAabT + o * 4608; const LAS bf16* as = (o < 2) ? sAt : sRt; const LAS bf16* bs = (o & 1) ? sKt : sBt;
            f32x4 acc = {0.f, 0.f, 0.f, 0.f};
            if (si <= ti) {
#pragma unroll
                for (int ks = 0; ks < 2; ++ks) acc = MFMA16(lfrag(as, 72, ti * 16, ks * 32, lane), lfrag(bs, 72, si * 16, ks * 32, lane), acc); }
            const int sc = si * 16 + cl, tr0 = ti * 16 + g4 * 4, dd = tr0 - sc - ((o < 2) ? 1 : 0);
#pragma unroll
            for (int j = 0; j < 4; ++j) acc[j] = (dd + j >= 0) ? acc[j] : 0.f;
            v2u w; w.x = pk2(acc[0], acc[1]); w.y = pk2(acc[2], acc[3]);
            *(LAS v2u*)(dst + sc * 72 + tr0) = w; }
        if (c < 31) { *(LAS v4u*)(sWA + t * 136 + c8) = pwl; *(LAS v4u*)(sWA + t * 136 + 64 + c8) = pal; *(LAS v4u*)(sGL + t * 136 + c8) = pg0; *(LAS v4u*)(sGL + t * 136 + 64 + c8) = pg1; if (wave < 4) RWKV_LORA_W(lane); }
        {   const int i = wave & 3; f32x4 Pm = {0.f, 0.f, 0.f, 0.f}, Qm = Pm, TT;
#pragma unroll
            for (int ks = 0; ks < 2; ++ks) { const bf16x8 af = lfrag(sAt, 72, i * 16, ks * 32, lane), bf = lfrag(sBt, 72, i * 16, ks * 32, lane);
                Pm = MFMA16(af, bf, Pm); Qm = MFMA16(bf, af, Qm); }
#pragma unroll
            for (int j = 0; j < 4; ++j) { Pm[j] = (cl < 4 * g4 + j) ? Pm[j] : 0.f; Qm[j] = (4 * g4 + j < cl) ? Qm[j] : 0.f;
                TT[j] = Qm[j] + ((4 * g4 + j == cl) ? 1.0f : 0.f); }
            const f32x4 z4 = {0.f, 0.f, 0.f, 0.f};
#pragma unroll
            for (int lvl = 0; lvl < 3; ++lvl) { const bf16x8 pf = dfrag(Pm), qf = dfrag(Qm);
                const f32x4 Pn = MFMA16(qf, pf, z4); if (lvl < 2) Qm = MFMA16(pf, qf, z4);
                Pm = Pn; TT = MFMA16(dfrag(Pm), dfrag(TT), TT); }
            if (wave < 4) { v2u w; w.x = pk2(TT[0], TT[1]); w.y = pk2(TT[2], TT[3]); *(LAS v2u*)((LAS unsigned char*)sTot + (i * 64 + lane) * 8) = w; }
        }
        __syncthreads();
        bf16x8 TTf[4];
#pragma unroll
        for (int i = 0; i < 4; ++i) { const v2u w = *(const LAS v2u*)((LAS unsigned char*)sTot + (i * 64 + lane) * 8); v4u x = {w.x, w.y, 0u, 0u}; TTf[i] = __builtin_bit_cast(bf16x8, x); }
        if (wave >= 4) { const int vt = wave - 4; const f32x4 zero4 = {0.f, 0.f, 0.f, 0.f};
            const bf16x8 h01 = dfrag2(Hs[0], Hs[1]), h23 = dfrag2(Hs[2], Hs[3]);
            f32x4 Z[4], Yt[4], Hn[4];
#pragma unroll
            for (int i = 0; i < 4; ++i) { Z[i] = zero4;
#pragma unroll
                for (int ks = 0; ks < 2; ++ks) Z[i] = MFMA16(trfrag(sAakT, 72, 32 * ks + 8 * g4, 32 * ks + 8 * g4 + 4, 16 * i, lane), trfrag(sV, 72, 32 * ks + 8 * g4, 32 * ks + 8 * g4 + 4, 16 * vt, lane), Z[i]);
                Z[i] = MFMA16(pfrag(sAt, 72, 16 * i, 0, 16, lane), h01, Z[i]); Z[i] = MFMA16(pfrag(sAt, 72, 16 * i, 32, 48, lane), h23, Z[i]); }
            Z[0] = MFMA16(TTf[0], dfrag(Z[0]), zero4);
            Z[1] = MFMA16(trfrag1(sAabT, 72, 4 * g4, 16, lane), dfrag(Z[0]), Z[1]);
            Z[1] = MFMA16(TTf[1], dfrag(Z[1]), zero4);
            Z[2] = MFMA16(trfrag(sAabT, 72, 4 * g4, 16 + 4 * g4, 32, lane), dfrag2(Z[0], Z[1]), Z[2]);
            Z[2] = MFMA16(TTf[2], dfrag(Z[2]), zero4);
            Z[3] = MFMA16(trfrag(sAabT, 72, 4 * g4, 16 + 4 * g4, 48, lane), dfrag2(Z[0], Z[1]), Z[3]);
            Z[3] = MFMA16(trfrag1(sAabT, 72, 32 + 4 * g4, 48, lane), dfrag(Z[2]), Z[3]);
            Z[3] = MFMA16(TTf[3], dfrag(Z[3]), zero4);
            const bf16x8 z01 = dfrag2(Z[0], Z[1]), z23 = dfrag2(Z[2], Z[3]);
#pragma unroll
            for (int i = 0; i < 4; ++i) {
                Yt[i] = MFMA16(trfrag(sArbT, 72, 4 * g4, 16 + 4 * g4, 16 * i, lane), z01, zero4); Yt[i] = MFMA16(trfrag(sArbT, 72, 32 + 4 * g4, 48 + 4 * g4, 16 * i, lane), z23, Yt[i]);
                Yt[i] = MFMA16(pfrag(sRt, 72, 16 * i, 0, 16, lane), h01, Yt[i]); Yt[i] = MFMA16(pfrag(sRt, 72, 16 * i, 32, 48, lane), h23, Yt[i]);
                const f32x4 gm = *(const LAS f32x4*)(sGam + 16 * i + 4 * g4);
                Hn[i] = Hs[i] * gm;
                Hn[i] = MFMA16(trfrag(sBh, 72, 4 * g4, 16 + 4 * g4, 16 * i, lane), z01, Hn[i]); Hn[i] = MFMA16(trfrag(sBh, 72, 32 + 4 * g4, 48 + 4 * g4, 16 * i, lane), z23, Hn[i]); }
#pragma unroll
            for (int ks = 0; ks < 2; ++ks) { const bf16x8 vf = trfrag(sV, 72, 32 * ks + 8 * g4, 32 * ks + 8 * g4 + 4, 16 * vt, lane);
#pragma unroll
                for (int i = 0; i < 4; ++i) {
                    Yt[i] = MFMA16(trfrag(sArkT, 72, 32 * ks + 8 * g4, 32 * ks + 8 * g4 + 4, 16 * i, lane), vf, Yt[i]);
                    Hn[i] = MFMA16(trfrag(sKh, 72, 32 * ks + 8 * g4, 32 * ks + 8 * g4 + 4, 16 * i, lane), vf, Hn[i]); } }
#pragma unroll
            for (int i = 0; i < 4; ++i) { Hs[i] = Hn[i];
#pragma unroll
                for (int j = 0; j < 4; ++j) sY[(16 * i + 4 * g4 + j) * 68 + 16 * vt + cl] = Yt[i][j]; }
        }
        else if (c < 31) RWKV_LORA(lane, cl, g4);
        __syncthreads();
        {   float y[8], s1 = 0.f, s2 = 0.f, o[8];
            const f32x4 y0 = *(const LAS f32x4*)(sY + t * 68 + c8), y1 = *(const LAS f32x4*)(sY + t * 68 + c8 + 4);
            const f32x4 g0 = gkeep0, g1 = gkeep1;
            float vv[8]; unpack8(*(const LAS v4u*)(sV + t * 72 + c8), vv);
#pragma unroll
            for (int j = 0; j < 4; ++j) { y[j] = y0[j]; y[4 + j] = y1[j]; }
#pragma unroll
            for (int j = 0; j < 8; ++j) s1 += y[j];
            const float mean = add8(s1) * (1.0f / 64.0f);
#pragma unroll
            for (int j = 0; j < 8; ++j) { y[j] -= mean; s2 += y[j] * y[j]; }
            const float rstd = __builtin_amdgcn_rsqf(add8(s2) * (1.0f / 64.0f) + RWKV_GN_EPS), bon = sBonus[t];
#pragma unroll
            for (int j = 0; j < 8; ++j) o[j] = (y[j] * rstd * sC[384 + c8 + j] + sC[448 + c8 + j] + bon * vv[j]) * (j < 4 ? g0[j & 3] : g1[j & 3]);
            if (!dry) *(GAS v4u*)(F.P + (m0 + t) * LDP + C_RV + hc) = pack8(o);
        }
    }
    __syncthreads();
}
#undef RWKV_LORA
#undef RWKV_LORA_W

__device__ __forceinline__ void gla_item(Frame& F, int item, bool dry = false) {
    const int b = item >> 4, h = (item >> 2) & 3, vs = item & 3, tid = F.tid, wave = F.wave;
    LAS bf16* sQE = (LAS bf16*)F.lds; LAS bf16* sKE = sQE + 64 * 136; LAS bf16* sQD = sKE + 64 * 136; LAS bf16* sKD = sQD + 64 * 136; LAS bf16* sST = sKD + 64 * 136;
    LAS bf16* sV = sST + 64 * 136; LAS bf16* sScT = sV + 64 * 72;
    LAS float* sB = (LAS float*)(sScT + 64 * 72); LAS float* sO = (LAS float*)sQE;     LAS bf16* sGalB = (LAS bf16*)(sB + 64 * 132); LAS float* sTot = sB + 64 * 132 + 1024;
    LAS float* sEm = sTot + 512; LAS float* sEp = sEm + 128; LAS float* sEl = sEp + 128; LAS float* sGn = sEl + 128; LAS bf16* sOG = (LAS bf16*)(sGn + 64);
    const int t = tid >> 3, c16 = (tid & 7) * 16, c8 = (tid & 7) * 8;
    for (int i = tid; i < 64 * 136 / 2; i += 512) ((LAS unsigned*)sST)[i] = 0u;
    if (tid < 64) sGn[tid] = F.in[I_GLA_NORM][vs * 64 + tid];
    bf16x8 awf; float ab;
    {   const int lane0 = F.lane, colw = h * 128 + wave * 16 + (lane0 & 15), gq = lane0 >> 4; float a8[8];
#pragma unroll
        for (int j = 0; j < 8; ++j) a8[j] = (gq < 2) ? F.in[I_GLA_A_W2][(8 * gq + j) * 512 + colw] : 0.f;
        awf = __builtin_bit_cast(bf16x8, pack8(a8)); ab = F.in[I_GLA_A_B][colw]; }
    f32x4 accS[4];
#pragma unroll
    for (int i = 0; i < 4; ++i) accS[i] = (f32x4){0.f, 0.f, 0.f, 0.f};
    const float qscale = 0.08838834764831845f;
    v4u pq0, pq1, pk0, pk1, pvv, pga[4];
    const int lane0 = F.lane, cl0 = lane0 & 15, g40 = lane0 >> 4;
    {   const bf16* row = F.P + ((size_t)b * SEQ + t) * LDP;
        pq0 = *(const v4u*)(row + C_Q + h * 128 + c16); pq1 = *(const v4u*)(row + C_Q + h * 128 + c16 + 8); pk0 = *(const v4u*)(row + C_K + h * 128 + c16); pk1 = *(const v4u*)(row + C_K + h * 128 + c16 + 8);
        pvv = *(const v4u*)(row + C_GV + h * 256 + vs * 64 + c8);
#pragma unroll
        for (int ti = 0; ti < 4; ++ti) { pga[ti] = (v4u){0u, 0u, 0u, 0u}; if (g40 < 2) pga[ti] = *(const v4u*)(F.P + ((size_t)b * SEQ + 16 * ti + cl0) * LDP + C_GAL + 8 * g40); } }
    f32x4 bN[4];
#define GLA_G2() do { const f32x4 z4_ = {0.f, 0.f, 0.f, 0.f}; \
        _Pragma("unroll") for (int ti = 0; ti < 4; ++ti) { const f32x4 acc_ = MFMA16(__builtin_bit_cast(bf16x8, pga[ti]), awf, z4_); \
            _Pragma("unroll") for (int j = 0; j < 4; ++j) bN[ti][j] = -fsoftplus(-(ab + acc_[j])) * (1.0f / 16.0f); } \
        float base_ = 0.f; \
        _Pragma("unroll") for (int ti = 0; ti < 4; ++ti) { bN[ti][1] += bN[ti][0]; bN[ti][2] += bN[ti][1]; bN[ti][3] += bN[ti][2]; const float sg_ = bN[ti][3]; \
            const float s0_ = __shfl(sg_, cl0), s1_ = __shfl(sg_, cl0 + 16), s2_ = __shfl(sg_, cl0 + 32), s3_ = __shfl(sg_, cl0 + 48); \
            const float ex_ = base_ + ((g40 > 0) ? s0_ : 0.f) + ((g40 > 1) ? s1_ : 0.f) + ((g40 > 2) ? s2_ : 0.f); base_ += (s0_ + s1_) + (s2_ + s3_); \
            _Pragma("unroll") for (int j = 0; j < 4; ++j) bN[ti][j] += ex_; } } while (0)
    GLA_G2();
    __syncthreads();
    for (int c = 0; c < 32; ++c) {
        const size_t m0 = (size_t)b * SEQ + c * 64;
        int lane = F.lane; asm volatile("" : "+v"(lane));
        const int cl = lane & 15, g4 = lane >> 4;
        const v4u cq0 = pq0, cq1 = pq1, ck0 = pk0, ck1 = pk1;
        *(LAS v4u*)(sV + t * 72 + c8) = pvv;
        {   const int col = wave * 16 + cl;
#pragma unroll
            for (int ti = 0; ti < 4; ++ti)
#pragma unroll
                for (int j = 0; j < 4; ++j) sB[(ti * 16 + g4 * 4 + j) * 132 + col] = bN[ti][j];
            if (g4 == 3) { sEm[col] = fexp(-bN[1][3]); sEp[col] = fexp(bN[1][3]); sEl[col] = fexp(bN[3][3]); } }
        __syncthreads();
        {   float qe[16], ke[16], qd[16], kd[16];
            float q[16], k[16];
            {   float tmp[8];
                unpack8(cq0, tmp);
#pragma unroll
                for (int j = 0; j < 8; ++j) q[j] = tmp[j];
                unpack8(cq1, tmp);
#pragma unroll
                for (int j = 0; j < 8; ++j) q[8 + j] = tmp[j];
                unpack8(ck0, tmp);
#pragma unroll
                for (int j = 0; j < 8; ++j) k[j] = tmp[j];
                unpack8(ck1, tmp);
#pragma unroll
                for (int j = 0; j < 8; ++j) k[8 + j] = tmp[j]; }
            if (c < 31) { const bf16* row = F.P + (m0 + 64 + t) * LDP;
                pq0 = *(const v4u*)(row + C_Q + h * 128 + c16); pq1 = *(const v4u*)(row + C_Q + h * 128 + c16 + 8); pk0 = *(const v4u*)(row + C_K + h * 128 + c16); pk1 = *(const v4u*)(row + C_K + h * 128 + c16 + 8);
                pvv = *(const v4u*)(row + C_GV + h * 256 + vs * 64 + c8);
#pragma unroll
                for (int ti = 0; ti < 4; ++ti) if (g4 < 2) pga[ti] = *(const v4u*)(F.P + (m0 + 64 + 16 * ti + cl) * LDP + C_GAL + 8 * g4); }
#pragma unroll
            for (int j4 = 0; j4 < 4; ++j4) {
                const f32x4 bb = *(const LAS f32x4*)(sB + t * 132 + c16 + 4 * j4), em = *(const LAS f32x4*)(sEm + c16 + 4 * j4), ep = *(const LAS f32x4*)(sEp + c16 + 4 * j4), el = *(const LAS f32x4*)(sEl + c16 + 4 * j4);
#pragma unroll
                for (int jj = 0; jj < 4; ++jj) { const int j = 4 * j4 + jj; const float eb = fexp(bb[jj]), ieb = __builtin_amdgcn_rcpf(eb);
                    qd[j] = q[j] * qscale * eb; qe[j] = qd[j] * em[jj]; const float ki = k[j] * ieb; ke[j] = ki * ep[jj]; kd[j] = ki * el[jj]; } }
            float tmp[8];
#pragma unroll
            for (int hh = 0; hh < 2; ++hh) {
#pragma unroll
                for (int j = 0; j < 8; ++j) tmp[j] = qe[8 * hh + j];
                *(LAS v4u*)(sQE + t * 136 + c16 + 8 * hh) = pack8(tmp);
#pragma unroll
                for (int j = 0; j < 8; ++j) tmp[j] = ke[8 * hh + j];
                *(LAS v4u*)(sKE + t * 136 + c16 + 8 * hh) = pack8(tmp);
#pragma unroll
                for (int j = 0; j < 8; ++j) tmp[j] = qd[8 * hh + j];
                *(LAS v4u*)(sQD + t * 136 + c16 + 8 * hh) = pack8(tmp);
#pragma unroll
                for (int j = 0; j < 8; ++j) tmp[j] = kd[8 * hh + j];
                *(LAS v4u*)(sKD + t * 136 + c16 + 8 * hh) = pack8(tmp); }
        }
        __syncthreads();
#pragma unroll
        for (int e = 0; e < 2; ++e) { const int tile = 2 * wave + e, ti = tile >> 2, si = tile & 3;
            f32x4 acc = {0.f, 0.f, 0.f, 0.f};
            if (si <= ti) {
#pragma unroll
                for (int ks = 0; ks < 4; ++ks) acc = MFMA16(lfrag(sQE, 136, ti * 16, ks * 32, lane), lfrag(sKE, 136, si * 16, ks * 32, lane), acc); }
            const int sc = si * 16 + cl, tr0 = ti * 16 + g4 * 4;
#pragma unroll
            for (int j = 0; j < 4; ++j) acc[j] = (sc <= tr0 + j) ? acc[j] : 0.f;
            v2u w; w.x = pk2(acc[0], acc[1]); w.y = pk2(acc[2], acc[3]);
            *(LAS v2u*)(sScT + sc * 72 + tr0) = w; }
        __syncthreads();
#pragma unroll
        for (int e = 0; e < 2; ++e) { const int tile = 2 * wave + e, ti = tile >> 2, vi = tile & 3;
            f32x4 acc = {0.f, 0.f, 0.f, 0.f};
#pragma unroll
            for (int ks = 0; ks < 2; ++ks) acc = MFMA16(trfrag(sScT, 72, 32 * ks + 8 * g4, 32 * ks + 8 * g4 + 4, 16 * ti, lane), trfrag(sV, 72, 32 * ks + 8 * g4, 32 * ks + 8 * g4 + 4, 16 * vi, lane), acc);
#pragma unroll
            for (int ks = 0; ks < 4; ++ks) acc = MFMA16(lfrag(sQD, 136, ti * 16, ks * 32, lane), lfrag(sST, 136, vi * 16, ks * 32, lane), acc);
#pragma unroll
            for (int j = 0; j < 4; ++j) sO[(ti * 16 + g4 * 4 + j) * 68 + vi * 16 + cl] = acc[j]; }
        {   const f32x4 dec = *(const LAS f32x4*)(sEl + wave * 16 + g4 * 4);
#pragma unroll
            for (int vi = 0; vi < 4; ++vi) accS[vi] = accS[vi] * dec;
#pragma unroll
            for (int ks = 0; ks < 2; ++ks) { const bf16x8 kf = trfrag(sKD, 136, 32 * ks + 8 * g4, 32 * ks + 8 * g4 + 4, 16 * wave, lane);
#pragma unroll
                for (int vi = 0; vi < 4; ++vi) accS[vi] = MFMA16(kf, trfrag(sV, 72, 32 * ks + 8 * g4, 32 * ks + 8 * g4 + 4, 16 * vi, lane), accS[vi]); } }
        if (c < 31) GLA_G2();
        __syncthreads();
#pragma unroll
        for (int vi = 0; vi < 4; ++vi) { v2u w; w.x = pk2(accS[vi][0], accS[vi][1]); w.y = pk2(accS[vi][2], accS[vi][3]);
            *(LAS v2u*)(sST + (vi * 16 + cl) * 136 + wave * 16 + g4 * 4) = w; }
        {   float o[8], ss = 0.f;
            const f32x4 o0 = *(const LAS f32x4*)(sO + t * 68 + c8), o1 = *(const LAS f32x4*)(sO + t * 68 + c8 + 4);
#pragma unroll
            for (int j = 0; j < 4; ++j) { o[j] = o0[j]; o[4 + j] = o1[j]; }
#pragma unroll
            for (int j = 0; j < 8; ++j) ss += o[j] * o[j];
            ss = add8(ss);
            if (!dry) { if ((tid & 7) == 0) F.GS[(m0 + t) * 16 + h * 4 + vs] = ss;
                *(GAS v4u*)(F.P + (m0 + t) * LDP + C_GV + h * 256 + vs * 64 + c8) = pack8(o); }
        }
    }
}
#undef GLA_G2

__device__ __forceinline__ void gla_fixup(Frame& F) {
    const int gw = F.lc * NWAVES + F.wave, NGW = GSZ * NWAVES, lane = F.lane;
    const int hd = lane >> 4, v0 = (lane & 15) * 16;
    float gn[16];
#pragma unroll
    for (int j = 0; j < 16; ++j) gn[j] = F.in[I_GLA_NORM][v0 + j];
    for (int m = gw; m < GROWS; m += 2 * NGW) {
        v4u ov[2][2], gvv[2][2]; float rs[2];
#pragma unroll
        for (int u = 0; u < 2; ++u) { const int mm = m + u * NGW; const bf16* prow = F.P + (size_t)mm * LDP;
            const f32x4 g4 = *(const f32x4*)(F.GS + (size_t)mm * 16 + hd * 4);
#pragma unroll
            for (int hh = 0; hh < 2; ++hh) { ov[u][hh] = *(const v4u*)(prow + C_GV + lane * 16 + 8 * hh); gvv[u][hh] = *(const v4u*)(prow + C_OG + lane * 16 + 8 * hh); }
            rs[u] = 1.0f / sqrtf(((g4[0] + g4[1]) + (g4[2] + g4[3])) * (1.0f / 256.0f) + GLA_NORM_EPS);
        }
#pragma unroll
        for (int u = 0; u < 2; ++u) { bf16* prow = F.P + (size_t)(m + u * NGW) * LDP;
#pragma unroll
            for (int hh = 0; hh < 2; ++hh) { float o[8], g[8]; unpack8(ov[u][hh], o); unpack8(gvv[u][hh], g);
#pragma unroll
                for (int j = 0; j < 8; ++j) o[j] = o[j] * rs[u] * gn[8 * hh + j] * (g[j] * fsig(g[j]));
                *(GAS v4u*)(prow + C_GV + lane * 16 + 8 * hh) = pack8(o); } }
    }
}
__device__ __forceinline__ void final_norm(Frame& F) {
    const int gw = F.lc * NWAVES + F.wave, NGW = GSZ * NWAVES, lane = F.lane;
    f32x4 gv[4];
#pragma unroll
    for (int j = 0; j < 4; ++j) gv[j] = ((const f32x4*)F.in[I_NORM_FINAL])[lane + 64 * j];
    for (int m = gw; m < GROWS; m += 2 * NGW) {
        float rs[2]; f32x4 v[2][4];
#pragma unroll
        for (int u = 0; u < 2; ++u) { const int mm = m + u * NGW;
            const f32x4* sq = (const f32x4*)(F.SQ2 + (size_t)mm * 16); const f32x4 s0 = sq[0], s1 = sq[1], s2 = sq[2], s3 = sq[3];
            const GAS f32x4* xr = (const GAS f32x4*)(F.out + (size_t)mm * D) + lane;
#pragma unroll
            for (int j = 0; j < 4; ++j) v[u][j] = xr[64 * j];
            const float tot = ((s0[0] + s0[1]) + (s0[2] + s0[3])) + ((s1[0] + s1[1]) + (s1[2] + s1[3])) + ((s2[0] + s2[1]) + (s2[2] + s2[3])) + ((s3[0] + s3[1]) + (s3[2] + s3[3]));
            rs[u] = 1.0f / sqrtf(tot * (1.0f / 1024.0f) + NORM_EPS); }
#pragma unroll
        for (int u = 0; u < 2; ++u) { GAS f32x4* xr = (GAS f32x4*)(F.out + (size_t)(m + u * NGW) * D) + lane;
#pragma unroll
            for (int j = 0; j < 4; ++j) xr[64 * j] = v[u][j] * rs[u] * gv[j]; }
    }
}
__device__ __forceinline__ void lin_pass(Frame& F, int blk) {
    const int tid = F.tid, r = tid >> 2, q = tid & 3; const size_t m = (size_t)blk * 128 + r;
    const bf16* row = F.P + m * LDP + C_WL + q * 64; const bool hasprev = (m % SEQ) != 0; const float* mu = F.in[I_MU] + 3072 + q * 64;
#pragma unroll
    for (int p = 0; p < 8; ++p) { float cur[8], prv[8], z[8];
        unpack8(*(const v4u*)(row + 8 * p), cur);
        if (hasprev) unpack8(*(const v4u*)(row - LDP + 8 * p), prv); else {
#pragma unroll
            for (int j = 0; j < 8; ++j) prv[j] = 0.f; }
#pragma unroll
        for (int j = 0; j < 8; ++j) { const float zz = cur[j] + (prv[j] - cur[j]) * mu[8 * p + j];
            z[j] = (q == 0) ? (1.0f - 2.0f * __builtin_amdgcn_rcpf(1.0f + fexp(2.0f * zz))) : ((q == 1) ? zz : fsig(zz)); }
        *(GAS v4u*)(F.LIN + m * 256 + q * 64 + 8 * p) = pack8(z); }
}
constexpr int N_PHASES = 10;
struct Args { const float* in[24]; float* out; unsigned char* ws; int ph_lo, ph_hi; };
__global__ void __launch_bounds__(NWAVES * 64, 2) mk_fwd(Args args) {
    extern __shared__ __attribute__((aligned(16))) unsigned char lds[];
    Frame F;
    F.lds = (LAS unsigned char*)lds;
    F.MISC = (volatile LAS unsigned*)(F.lds + MISC_OFF);
    F.tid = threadIdx.x; F.lane = F.tid & 63; F.wave = __builtin_amdgcn_readfirstlane(F.tid >> 6);
    F.G = gridDim.x; { const int bx = blockIdx.x; F.vcu = (F.G % 8 == 0) ? (bx % 8) * (F.G / 8) + bx / 8 : bx; }
    unsigned char* ws = args.ws;
    F.ctl = (gu32*)(ws + WS_CTL);
#pragma unroll
    for (int i = 0; i < 24; ++i) F.in[i] = args.in[i];
    F.out = args.out;
    F.WIN = (bf16*)(ws + WS_WIN); F.WBR = (bf16*)(ws + WS_WBR); F.WOUT = (bf16*)(ws + WS_WOUT); F.WUP = (bf16*)(ws + WS_WUP); F.WDN = (bf16*)(ws + WS_WDN);
    F.LW = (bf16*)(ws + WS_LW); F.LA = (bf16*)(ws + WS_LA); F.LG = (bf16*)(ws + WS_LG); F.P = (bf16*)(ws + WS_P); F.XN = (bf16*)args.out;
    F.LIN = (bf16*)(ws + WS_LIN);
    F.GS = (float*)(ws + WS_GS); F.SQ1 = (float*)(ws + WS_SQ1); F.SQ2 = (float*)(ws + WS_SQ2);
    if (F.tid < 64) ((LAS unsigned*)(F.lds + MISC_OFF))[F.tid] = 0u;
    __syncthreads();
    const int lo = args.ph_lo, hi = args.ph_hi;
#if GRP_MAP == 1
    constexpr int GWGM = 8, GREMAP = 0;
#else
    constexpr int GWGM = (NGRP <= 8) ? 8 / NGRP : 1, GREMAP = 1;
#endif
#if GRP_MAP == 1
    F.gid = F.vcu / GSZ; F.lc = F.vcu % GSZ; F.cg = F.lc;
#else
    { constexpr int PX = (GSZ >= 8) ? GSZ / 8 : 1;
      F.gid = F.vcu % NGRP; F.lc = F.vcu / NGRP; F.cg = (F.lc % PX) * 8 + F.lc / PX; }
#endif
    XcdBarrier bar = xcd_barrier_post((unsigned*)(F.ctl + CW_BAR), F.MISC + 8, gridDim.x);
    XcdBarrier gbar = xcd_barrier_post((unsigned*)(F.ctl + CW_GBAR + 4096 * F.gid), F.MISC + 10, GSZ);
#define IN(k) (lo <= (k) && (k) < hi)
#define SEAM(k) do { if (IN(k) && IN((k) + 1)) { if ((k) == 0) xcd_barrier(bar); else xcd_barrier(gbar); } } while (0)
    Frame Fg = F;
    {   const size_t r0 = (size_t)F.gid * GROWS;
        Fg.P = F.P + r0 * LDP; Fg.XN = F.XN + r0 * 2048; Fg.out = F.out + r0 * D; Fg.in[I_X] = F.in[I_X] + r0 * D; Fg.GS = F.GS + r0 * 16; Fg.SQ1 = F.SQ1 + r0 * 16; Fg.SQ2 = F.SQ2 + r0 * 16; }
    const int item = F.gid * GSZ + F.lc;
    LAS unsigned char* ring = F.lds;

    if (IN(0)) { p0_prologue(F); } SEAM(0);
#if defined(GSTAG) && GSTAG > 0
    if (F.gid > 0) { const unsigned long long t0 = __builtin_amdgcn_s_memrealtime(); while (__builtin_amdgcn_s_memrealtime() - t0 < (unsigned long long)(GSTAG) * F.gid) __builtin_amdgcn_s_sleep(8); }
#endif
    if (IN(1)) {
        pg8::Gemm g{Fg.XN, F.WIN, GROWS, NA, D, D, D}; pg8::StaticOrder S; S.init(GROWS, NA, GSZ, F.cg, GWGM, GREMAP);
        pg8::EpiStore<0> E{Fg.P, LDP, NA_VALID};
        pg8::gemm_phase<pg8::EpiStore<0>, pg8::StaticOrder, true, true>(ring, g, S, E);
    } SEAM(1);
#ifndef RWKV_IMPL
#define RWKV_IMPL rwkv_item
#endif
#ifndef GLA_IMPL
#define GLA_IMPL gla_item
#endif
    if (IN(2)) { lin_pass(F, item); GLA_IMPL(F, item); } SEAM(2);
    if (IN(3)) { __syncthreads(); RWKV_IMPL(F, item); }
    SEAM(3);
    if (IN(4)) {
        gla_fixup(Fg);
        pg8::Gemm g{Fg.XN, F.WIN + (size_t)NA * D, GROWS, NG, D, D, D}; pg8::StaticOrder S; S.init(GROWS, NG, GSZ, F.cg, GWGM, GREMAP);
        pg8::EpiStore<1> E{Fg.P + C_SG, LDP, NG};
        pg8::gemm_phase<pg8::EpiStore<1>, pg8::StaticOrder, true, true>(ring, g, S, E);
    } SEAM(4);
    if (IN(5)) {
        pg8::Gemm g{Fg.P + C_GV, F.WBR, GROWS, D, 2 * D, LDP, 2 * D}; pg8::StaticOrder S; S.init(GROWS, D, GSZ, F.cg, GWGM, GREMAP);
        pg8::EpiMerge2 E{Fg.P + C_SG, Fg.P + C_MIX, LDP};
        pg8::gemm_phase<pg8::EpiMerge2, pg8::StaticOrder, true, true>(ring, g, S, E);
    } SEAM(5);
    if (IN(6)) {
        pg8::Gemm g{Fg.P + C_MIX, F.WOUT, GROWS, D, D, LDP, D}; pg8::StaticOrder S; S.init(GROWS, D, GSZ, F.cg, GWGM, GREMAP);
        pg8::EpiRes<true> E{Fg.in[I_X], Fg.out, Fg.P + C_A2, LDP, Fg.SQ1};
        pg8::gemm_phase<pg8::EpiRes<true>, pg8::StaticOrder, true, true>(ring, g, S, E);
    } SEAM(6);
    if (IN(7)) {
        pg8::Gemm g{Fg.P + C_A2, F.WUP, GROWS, FF, D, LDP, D}; pg8::StaticOrder S; S.init(GROWS, FF, GSZ, F.cg, GWGM, GREMAP);
        pg8::EpiUp E{Fg.SQ1, Fg.P + C_H, LDP, NORM_EPS};
        pg8::gemm_phase<pg8::EpiUp, pg8::StaticOrder, true, true>(ring, g, S, E);
    } SEAM(7);
    if (IN(8)) {
        pg8::Gemm g{Fg.P + C_H, F.WDN, GROWS, D, FF, LDP, FF}; pg8::StaticOrder S; S.init(GROWS, D, GSZ, F.cg, GWGM, GREMAP);
        pg8::EpiResB E{Fg.P + C_A2, LDP, Fg.out, Fg.SQ2};
        pg8::gemm_phase<pg8::EpiResB, pg8::StaticOrder, true, true>(ring, g, S, E);
    } SEAM(8);
    if (IN(9)) { final_norm(Fg); }
#undef IN
#undef SEAM
}

extern "C" void kernel_launch(void* const* d_in, const int* in_sizes, int n_in, void* d_out, int out_size, void* d_ws, size_t ws_size, hipStream_t stream) {
    static int grid = 0;
    if (grid == 0) {
        if (n_in != 24 || in_sizes[0] != M * D || out_size != M * D || ws_size < WS_END) { fprintf(stderr, "kernel_launch: unexpected shapes (n_in %d, in0 %d, out %d, ws %zu, need %zu)\n", n_in, n_in > 0 ? in_sizes[0] : -1, out_size, ws_size, (size_t)WS_END); grid = -1; return; }
        int dev = 0, cus = 0, per_cu = 0;
        if (hipGetDevice(&dev) != hipSuccess || hipDeviceGetAttribute(&cus, hipDeviceAttributeMultiprocessorCount, dev) != hipSuccess) { grid = -1; return; }
        if (hipFuncSetAttribute((const void*)mk_fwd, hipFuncAttributeMaxDynamicSharedMemorySize, LDS_BYTES) != hipSuccess) { fprintf(stderr, "kernel_launch: hipFuncSetAttribute failed\n"); grid = -1; return; }
        if (hipOccupancyMaxActiveBlocksPerMultiprocessor(&per_cu, (const void*)mk_fwd, NWAVES * 64, LDS_BYTES) != hipSuccess || per_cu < 1) { fprintf(stderr, "kernel_launch: occupancy query says %d blocks per CU\n", per_cu); }
        (void)hipGetLastError();
        grid = cus;
        if (grid != 256) { fprintf(stderr, "kernel_launch: built for a 256-CU device (one mixer item per workgroup); found %d CUs; nothing launched\n", cus); grid = -1; return; }
    }
    if (grid < 0) return;
    (void)hipMemsetAsync((char*)d_ws + WS_CTL, 0, CTL_ZERO_BYTES, stream);
    Args a{};
    for (int i = 0; i < 24; ++i) a.in[i] = (const float*)d_in[i];
    a.out = (float*)d_out; a.ws = (unsigned char*)d_ws;
#if MK_SINGLE
    a.ph_lo = 0; a.ph_hi = N_PHASES;
    hipLaunchKernelGGL(mk_fwd, dim3(grid), dim3(NWAVES * 64), LDS_BYTES, stream, a);
#else
    for (int p = 0; p < N_PHASES; ++p) { a.ph_lo = p; a.ph_hi = p + 1; hipLaunchKernelGGL(mk_fwd, dim3(grid), dim3(NWAVES * 64), LDS_BYTES, stream, a); }
#endif
}
```
